# Optimizing an MI355X kernel written in HIP

```python
import math
import jax, jax.numpy as jnp
from jax import lax
import numpy as np

D_MODEL = 1024
BATCH = 8
SEQ = 4096
DEPTH = 1

D_MIX = D_MODEL
D_POOL = D_MIX // 2
D_CONV = D_MIX - D_POOL
POOL_WINDOWS = (2, 4, 8, 16)
N_POOL_GROUPS = len(POOL_WINDOWS)
POOL_GROUP_DIM = D_POOL // N_POOL_GROUPS
N_CONV_HEADS = 8
CONV_WIDTH = 3
D_IN_PROJ = D_POOL + 3 * D_CONV

N_EXPERTS = 32
TOP_K = 4
D_FF = D_MODEL
SWIGLU_LIMIT = 7.0
SWIGLU_ALPHA = 1.702
EXPERT_BLOCK = 128

PLE_DIM = 256

DEEPNORM_ALPHA = (2.0 * DEPTH) ** 0.25
DEEPNORM_BETA = (8.0 * DEPTH) ** -0.25
LN_EPS = 1e-5

kernel_name = "hybrid_pool_shortconv_moe_deepnorm"


def layer_norm(x, g, b):
    xf = x.astype(jnp.float32)
    mu = jnp.mean(xf, axis=-1, keepdims=True)
    var = jnp.mean(jnp.square(xf - mu), axis=-1, keepdims=True)
    y = (xf - mu) * lax.rsqrt(var + LN_EPS)
    return (y * g.astype(jnp.float32) + b.astype(jnp.float32)).astype(x.dtype)


def pool_mixer(v, pool_mix, pool_scale):
    B, S, _ = v.shape
    vf = v.astype(jnp.float32)
    t = jnp.arange(S)
    outs = []
    for g, w in enumerate(POOL_WINDOWS):
        vg = vf[..., g * POOL_GROUP_DIM:(g + 1) * POOL_GROUP_DIM]
        cs = jnp.cumsum(vg, axis=1)
        lagged = jnp.pad(cs, ((0, 0), (w, 0), (0, 0)))[:, :S]
        cnt = jnp.minimum(t + 1, w).astype(jnp.float32)[None, :, None]
        outs.append((cs - lagged) / cnt - vg)
    d = jnp.stack(outs, axis=2).astype(v.dtype)
    y = jnp.einsum('bsgc,gcd->bsgd', d, pool_mix).reshape(B, S, D_POOL)
    return y * pool_scale


def conv_mixer(b_gate, c_gate, v, conv_w):
    S = v.shape[1]
    u = c_gate * v
    up = jnp.pad(u, ((0, 0), (CONV_WIDTH - 1, 0), (0, 0)))
    y = conv_w[0] * up[:, 0:S]
    for k in range(1, CONV_WIDTH):
        y = y + conv_w[k] * up[:, k:k + S]
    return b_gate * y


def clamped_swiglu_expert(xb, w_gu, b_gu, w_dn, b_dn):
    gu = xb @ w_gu + b_gu
    gate = jnp.minimum(gu[:, :D_FF], SWIGLU_LIMIT)
    up = jnp.clip(gu[:, D_FF:], -SWIGLU_LIMIT, SWIGLU_LIMIT)
    glu = gate * jax.nn.sigmoid(SWIGLU_ALPHA * gate)
    return ((up + 1.0) * glu) @ w_dn + b_dn


def moe(h, router_w, router_b, w_gate_up, b_gate_up, w_down, b_down):
    B, S, D = h.shape
    N = B * S
    hf = h.reshape(N, D)
    logits = (hf @ router_w + router_b).astype(jnp.float32)
    top_v, top_i = lax.top_k(logits, TOP_K)
    gates = jax.nn.softmax(top_v, axis=-1)
    A = N * TOP_K
    flat_e = top_i.reshape(A).astype(jnp.int32)
    flat_tok = jnp.repeat(jnp.arange(N, dtype=jnp.int32), TOP_K)
    flat_g = gates.reshape(A)
    order = jnp.argsort(flat_e)
    e_sorted = flat_e[order]
    counts = jax.ops.segment_sum(jnp.ones((A,), jnp.int32), flat_e, num_segments=N_EXPERTS)
    offsets = jnp.cumsum(counts) - counts
    padded = ((counts + EXPERT_BLOCK - 1) // EXPERT_BLOCK) * EXPERT_BLOCK
    pad_end = jnp.cumsum(padded)
    pad_start = pad_end - padded
    dest = pad_start[e_sorted] + (jnp.arange(A, dtype=jnp.int32) - offsets[e_sorted])
    P = A + N_EXPERTS * EXPERT_BLOCK
    NB = P // EXPERT_BLOCK
    row_tok = jnp.zeros((P,), jnp.int32).at[dest].set(flat_tok[order])
    row_gate = jnp.zeros((P,), jnp.float32).at[dest].set(flat_g[order])
    blk_start = jnp.arange(NB, dtype=jnp.int32) * EXPERT_BLOCK
    blk_e = jnp.minimum(jnp.sum(blk_start[:, None] >= pad_end[None, :], axis=1),
                        N_EXPERTS - 1).astype(jnp.int32)
    xb = hf[row_tok].reshape(NB, EXPERT_BLOCK, D)

    def run_block(args):
        xblk, e = args
        return clamped_swiglu_expert(xblk, w_gate_up[e], b_gate_up[e], w_down[e], b_down[e])

    yb = lax.map(run_block, (xb, blk_e)).reshape(P, D)
    y = jax.ops.segment_sum(yb * row_gate[:, None].astype(yb.dtype), row_tok, num_segments=N)
    return y.reshape(B, S, D)


def setup_inputs(seed: int = 0) -> dict:
    key = jax.random.key(seed)
    ks = jax.random.split(key, 24)
    L, D, E, F = DEPTH, D_MODEL, N_EXPERTS, D_FF
    nrm = lambda k, shape, s: jax.random.normal(k, shape, jnp.float32) * s
    return {
        "x": nrm(ks[0], (BATCH, SEQ, D), 1.0),
        "p": nrm(ks[1], (L, BATCH, SEQ, PLE_DIM), 1.0),
        "w_in": nrm(ks[2], (L, D, D_IN_PROJ), D ** -0.5),
        "pool_mix": nrm(ks[3], (L, N_POOL_GROUPS, POOL_GROUP_DIM, POOL_GROUP_DIM), POOL_GROUP_DIM ** -0.5),
        "pool_scale": 1.0 + nrm(ks[4], (L, D_POOL), 0.1),
        "conv_w": nrm(ks[5], (L, CONV_WIDTH, D_CONV), CONV_WIDTH ** -0.5),
        "w_out": nrm(ks[6], (L, D_MIX, D), D_MIX ** -0.5 * DEEPNORM_BETA),
        "ln1_g": 1.0 + nrm(ks[7], (L, D), 0.02),
        "ln1_b": nrm(ks[8], (L, D), 0.02),
        "router_w": nrm(ks[9], (L, D, E), D ** -0.5),
        "router_b": nrm(ks[10], (L, E), 0.01),
        "w_gate_up": nrm(ks[11], (L, E, D, 2 * F), D ** -0.5),
        "b_gate_up": nrm(ks[12], (L, E, 2 * F), 0.02),
        "w_down": nrm(ks[13], (L, E, F, D), F ** -0.5 * DEEPNORM_BETA),
        "b_down": nrm(ks[14], (L, E, D), 0.02),
        "ln2_g": 1.0 + nrm(ks[15], (L, D), 0.02),
        "ln2_b": nrm(ks[16], (L, D), 0.02),
        "ple_proj": nrm(ks[17], (L, PLE_DIM, D), PLE_DIM ** -0.5 * DEEPNORM_BETA),
        "ple_gate_w": nrm(ks[18], (L, D, D), D ** -0.5),
        "ple_gate_b": nrm(ks[19], (L, D), 0.02),
        "ln3_g": 1.0 + nrm(ks[20], (L, D), 0.02),
        "ln3_b": nrm(ks[21], (L, D), 0.02),
    }


def reference(x, p, w_in, pool_mix, pool_scale, conv_w, w_out, ln1_g, ln1_b,
              router_w, router_b, w_gate_up, b_gate_up, w_down, b_down,
              ln2_g, ln2_b, ple_proj, ple_gate_w, ple_gate_b, ln3_g, ln3_b):
    for i in range(DEPTH):
        proj = x @ w_in[i]
        v_pool = proj[..., :D_POOL]
        b_gate = proj[..., D_POOL:D_POOL + D_CONV]
        c_gate = proj[..., D_POOL + D_CONV:D_POOL + 2 * D_CONV]
        v_conv = proj[..., D_POOL + 2 * D_CONV:]
        y_pool = pool_mixer(v_pool, pool_mix[i], pool_scale[i])
        y_conv = conv_mixer(b_gate, c_gate, v_conv, conv_w[i])
        mix = jnp.concatenate([y_pool, y_conv], axis=-1) @ w_out[i]
        x = layer_norm(DEEPNORM_ALPHA * x + mix, ln1_g[i], ln1_b[i])
        ffn = moe(x, router_w[i], router_b[i], w_gate_up[i], b_gate_up[i], w_down[i], b_down[i])
        x = layer_norm(DEEPNORM_ALPHA * x + ffn, ln2_g[i], ln2_b[i])
        gate = jax.nn.sigmoid((x @ ple_gate_w[i] + ple_gate_b[i]).astype(jnp.float32)).astype(x.dtype)
        ple = p[i] @ ple_proj[i]
        x = layer_norm(DEEPNORM_ALPHA * x + gate * ple, ln3_g[i], ln3_b[i])
    return x
```

```cpp
#include <hip/hip_runtime.h>
#include <cstdio>
#include <cstdint>

#ifndef MK_N_LAUNCHES
#define MK_N_LAUNCHES 1
#endif

#define LAS __attribute__((address_space(3)))
#define GAS __attribute__((address_space(1)))
typedef unsigned short bf16_t;
typedef short bf16x8 __attribute__((ext_vector_type(8)));
typedef float f32x4 __attribute__((ext_vector_type(4)));
typedef float f32x2 __attribute__((ext_vector_type(2)));
typedef unsigned u32x4 __attribute__((ext_vector_type(4)));
typedef unsigned u32x2 __attribute__((ext_vector_type(2)));
typedef GAS unsigned gu32;

constexpr int M = 32768, D = 1024, SEQ = 4096, DIN = 2048, NE = 32, TOPK = 4, FF = 1024, PLE = 256, DPOOL = 512;
constexpr int NA = M * TOPK;
constexpr int LCAP = M;
constexpr int MAXTILES = NA / 256 + NE;
constexpr float ALPHA = 1.189207115002721f;
constexpr float LN_EPS = 1e-5f;
constexpr float SW_LIMIT = 7.0f, SW_ALPHA = 1.702f;
constexpr int NPHASE = 10;

constexpr size_t MiB = 1u << 20;
constexpr size_t WS_CTL = 0, CTL_ZERO_BYTES = 1 * MiB;
constexpr size_t WS_WIN = 1 * MiB;
constexpr size_t WS_W2 = 5 * MiB;
constexpr size_t WS_WG = 7 * MiB;
constexpr size_t WS_WP = 9 * MiB;
constexpr size_t WS_TG = 10 * MiB;
constexpr size_t WS_LIST = 11 * MiB;
constexpr size_t WS_WGU = 16 * MiB;
constexpr size_t WS_WDN = 144 * MiB;
constexpr size_t WS_XB1 = 208 * MiB;
constexpr size_t WS_PLE = 272 * MiB;
constexpr size_t WS_HID = 336 * MiB;
constexpr size_t WS_PROJ = 336 * MiB;
constexpr size_t WS_A2 = 464 * MiB;
constexpr size_t WS_XB = 528 * MiB;
constexpr size_t WS_PB = 592 * MiB;
constexpr size_t WS_Y = 608 * MiB;
constexpr size_t WS_END = 864 * MiB;
static_assert(WS_HID + (size_t)MAXTILES * 256 * 1024 * 2 <= WS_Y, "hidden fits");
constexpr int CW_TMO = 0, CW_CODE = 1, CW_CNT = 64  , CW_BAR = 4096;

constexpr int RING_BYTES = 131072;
constexpr int L_MISC = RING_BYTES;
constexpr int L_TST = RING_BYTES + 128;
constexpr int L_CNT = RING_BYTES + 272;
constexpr int L_UT = RING_BYTES + 640;
constexpr int L_HIST = RING_BYTES + 1664;
constexpr int L_BASE = RING_BYTES + 1792;
constexpr int L_ASG = RING_BYTES + 2048;
constexpr int LDS_BYTES = 147456;
static_assert(L_ASG + 2048 <= LDS_BYTES, "LDS map");

#define RLX_AGENT __ATOMIC_RELAXED, __HIP_MEMORY_SCOPE_AGENT
#define LDS_WAIT() asm volatile("s_waitcnt lgkmcnt(0)" ::: "memory")
#define VM_WAIT() asm volatile("s_waitcnt vmcnt(0)" ::: "memory")

__device__ __forceinline__ unsigned cvt_pk_bf16(float lo, float hi) { unsigned r; asm volatile("v_cvt_pk_bf16_f32 %0, %1, %2" : "=v"(r) : "v"(lo), "v"(hi)); return r; }
__device__ __forceinline__ float bf_lo(unsigned w) { return __uint_as_float(w << 16); }
__device__ __forceinline__ float bf_hi(unsigned w) { return __uint_as_float(w & 0xffff0000u); }
__device__ __forceinline__ float wave_sum(float v) {
#pragma unroll
    for (int o = 1; o < 64; o <<= 1) v += __shfl_xor(v, o);
    return v;
}

namespace pg8 {
constexpr int BM = 256, BK = 64, HALF = 128, HTB = HALF * BK * 2, STAGE_BYTES = 8 * HTB, NXCD = 8, WGM = 8;
__host__ __device__ __forceinline__ int lds_byte(int r, int c) { const int st = (r >> 4) * 2 + (c >> 5), rr = r & 15, cc = c & 31, ob = rr * 64 + cc * 2; return st * 1024 + (ob ^ (((ob >> 9) & 1) << 5)); }
__host__ __device__ __forceinline__ void stage_rc(int b, int& R, int& C) { const int st = b / 1024, sb = b % 1024, swz = sb ^ (((sb >> 9) & 1) << 5); R = (st >> 1) * 16 + swz / 64; C = (st & 1) * 32 + (swz % 64) / 2; }
__host__ __device__ __forceinline__ int perm32(int rho) { const int n = rho >> 4, i = rho & 15; return 8 * (i >> 2) + 4 * n + (i & 3); }

struct Unit { const char* A; const char* B; int pm, pn, e, lbase, nvalid; };

struct DenseOrder {
    static constexpr bool GATHER = false;
    const char* A; const char* Bt; int K, nM, nN, nwg, G, c;
    __device__ __forceinline__ void init(const void* A_, const void* Bt_, int M_, int N_, int K_, int G_, int c_) { A = (const char*)A_; Bt = (const char*)Bt_; K = K_; nM = M_ / BM; nN = N_ / BM; nwg = nM * nN; G = G_; c = c_; }
    __device__ __forceinline__ bool next(int i, Unit& u) const {
        const long L = (long)i * G + c; if (L >= nwg) return false;
        int wgid = (int)L; { const int q = nwg / NXCD, r = nwg % NXCD, xcd = wgid % NXCD, off = wgid / NXCD; wgid = (xcd < r ? xcd * (q + 1) : r * (q + 1) + (xcd - r) * q) + off; }
        const int nig = WGM * nN, gid = wgid / nig, fm = gid * WGM, gsz = (nM - fm) < WGM ? (nM - fm) : WGM;
        u.pm = fm + ((wgid % nig) % gsz); u.pn = (wgid % nig) / gsz;
        u.A = A + (size_t)u.pm * BM * K * 2; u.B = Bt + (size_t)u.pn * BM * K * 2; u.e = 0; u.lbase = 0; u.nvalid = BM; return true;
    }
    __device__ __forceinline__ void rows(const Unit&, int R0, unsigned (&off)[4]) const {
#pragma unroll
        for (int j = 0; j < 4; ++j) off[j] = (unsigned)((R0 + 64 * j) * K * 2);
    }
};

struct MoeOrder {
    const LAS int* ut; const char* A; const char* Bt; const int* list; int K; size_t bstride_e; bool gather;
    __device__ __forceinline__ bool next_(int i, Unit& u) const {
        if (i >= 32) return false;
        const LAS int* t = ut + i * 8;
        const int e = __builtin_amdgcn_readfirstlane(t[0]), tile = __builtin_amdgcn_readfirstlane(t[1]), pn = __builtin_amdgcn_readfirstlane(t[2]), valid = __builtin_amdgcn_readfirstlane(t[3]);
        const int lb = __builtin_amdgcn_readfirstlane(t[4]), nv = __builtin_amdgcn_readfirstlane(t[5]);
        if (!valid) return false;
        u.e = e; u.pm = tile; u.pn = pn; u.lbase = lb; u.nvalid = nv;
        u.B = Bt + (size_t)e * bstride_e + (size_t)pn * BM * K * 2;
        u.A = gather ? A : A + (size_t)tile * BM * K * 2;
        return true;
    }
};
struct MoeGuOrder : MoeOrder {
    static constexpr bool GATHER = true;
    __device__ __forceinline__ bool next(int i, Unit& u) const { return next_(i, u); }
    __device__ __forceinline__ void rows(const Unit& u, int R0, unsigned (&off)[4]) const {
#pragma unroll
        for (int j = 0; j < 4; ++j) { const int r = R0 + 64 * j; int aid = 0; if (r < u.nvalid) aid = list[u.lbase + r]; off[j] = (unsigned)(aid >> 2) * (unsigned)(K * 2); }
    }
};
struct MoeDnOrder : MoeOrder {
    static constexpr bool GATHER = false;
    __device__ __forceinline__ bool next(int i, Unit& u) const { return next_(i, u); }
    __device__ __forceinline__ void rows(const Unit&, int R0, unsigned (&off)[4]) const {
#pragma unroll
        for (int j = 0; j < 4; ++j) off[j] = (unsigned)((R0 + 64 * j) * K * 2);
    }
};

struct EpiBf16 {
    static constexpr bool PERM = true;
    bf16_t* O; int ldc;
    __device__ __forceinline__ void operator()(const f32x4 (&acc)[2][2][4][2], const Unit& u, int wr, int wc, int fr, int fq) const {
        const int row0 = u.pm * BM + wr * 64 + fr, col0 = u.pn * BM + wc * 32 + 8 * fq;
#pragma unroll
        for (int ai = 0; ai < 2; ++ai)
#pragma unroll
            for (int m = 0; m < 4; ++m) { bf16_t* rowp = O + (size_t)(row0 + ai * HALF + m * 16) * ldc + col0;
#pragma unroll
                for (int bj = 0; bj < 2; ++bj) { const f32x4 v0 = acc[ai][bj][m][0], v1 = acc[ai][bj][m][1];
                    u32x4 w; w.x = cvt_pk_bf16(v0[0], v0[1]); w.y = cvt_pk_bf16(v0[2], v0[3]); w.z = cvt_pk_bf16(v1[0], v1[1]); w.w = cvt_pk_bf16(v1[2], v1[3]);
                    *(u32x4*)(rowp + bj * HALF) = w; } }
    }
};
struct EpiH1 {
    static constexpr bool PERM = false;
    const float* x; float* out;
    __device__ __forceinline__ void operator()(const f32x4 (&acc)[2][2][4][2], const Unit& u, int wr, int wc, int fr, int fq) const {
        const int row0 = u.pm * BM + wr * 64 + fr, col0 = u.pn * BM + wc * 32 + 4 * fq;
#pragma unroll
        for (int ai = 0; ai < 2; ++ai)
#pragma unroll
            for (int m = 0; m < 4; ++m) { const size_t off = (size_t)(row0 + ai * HALF + m * 16) * D + col0;
#pragma unroll
                for (int bj = 0; bj < 2; ++bj)
#pragma unroll
                    for (int n = 0; n < 2; ++n) { const f32x4 xv = *(const f32x4*)(x + off + bj * HALF + n * 16); *(f32x4*)(out + off + bj * HALF + n * 16) = xv * ALPHA + acc[ai][bj][m][n]; }
                asm volatile("" ::: "memory"); }
    }
};
struct EpiGU {
    static constexpr bool PERM = true;
    bf16_t* H; const float* bgu;
    __device__ __forceinline__ void operator()(const f32x4 (&acc)[2][2][4][2], const Unit& u, int wr, int wc, int fr, int fq) const {
        const int row0 = u.pm * BM + wr * 64 + fr, cc = u.pn * HALF + wc * 32 + 8 * fq;
        const float* bp = bgu + (size_t)u.e * (2 * FF) + cc;
        f32x4 bg[2], bu[2];
#pragma unroll
        for (int n = 0; n < 2; ++n) { bg[n] = *(const f32x4*)(bp + 4 * n); bu[n] = *(const f32x4*)(bp + FF + 4 * n); }
#pragma unroll
        for (int ai = 0; ai < 2; ++ai)
#pragma unroll
            for (int m = 0; m < 4; ++m) { bf16_t* rowp = H + (size_t)(row0 + ai * HALF + m * 16) * FF + cc; float h[8];
#pragma unroll
                for (int n = 0; n < 2; ++n)
#pragma unroll
                    for (int i = 0; i < 4; ++i) {
                        const float g = fminf(acc[ai][0][m][n][i] + bg[n][i], SW_LIMIT);
                        const float up = fminf(fmaxf(acc[ai][1][m][n][i] + bu[n][i], -SW_LIMIT), SW_LIMIT);
                        const float sg = __builtin_amdgcn_rcpf(1.0f + __builtin_amdgcn_exp2f(g * (-SW_ALPHA * 1.4426950408889634f)));
                        h[4 * n + i] = (up + 1.0f) * (g * sg); }
                u32x4 w; w.x = cvt_pk_bf16(h[0], h[1]); w.y = cvt_pk_bf16(h[2], h[3]); w.z = cvt_pk_bf16(h[4], h[5]); w.w = cvt_pk_bf16(h[6], h[7]);
                *(u32x4*)rowp = w; }
    }
};
struct EpiDown {
    static constexpr bool PERM = true;
    bf16_t* Y; const float* bdn; const int* list;
    __device__ __forceinline__ void operator()(const f32x4 (&acc)[2][2][4][2], const Unit& u, int wr, int wc, int fr, int fq) const {
        const int col0 = u.pn * BM + wc * 32 + 8 * fq;
        const float* bp = bdn + (size_t)u.e * D + col0;
        f32x4 bv[2][2];
#pragma unroll
        for (int bj = 0; bj < 2; ++bj)
#pragma unroll
            for (int n = 0; n < 2; ++n) bv[bj][n] = *(const f32x4*)(bp + bj * HALF + 4 * n);
#pragma unroll
        for (int ai = 0; ai < 2; ++ai)
#pragma unroll
            for (int m = 0; m < 4; ++m) { const int r = ai * HALF + wr * 64 + m * 16 + fr;
                if (r < u.nvalid) { const int aid = list[u.lbase + r]; bf16_t* rowp = Y + (size_t)aid * D + col0;
#pragma unroll
                    for (int bj = 0; bj < 2; ++bj) { const f32x4 v0 = acc[ai][bj][m][0] + bv[bj][0], v1 = acc[ai][bj][m][1] + bv[bj][1];
                        u32x4 w; w.x = cvt_pk_bf16(v0[0], v0[1]); w.y = cvt_pk_bf16(v0[2], v0[3]); w.z = cvt_pk_bf16(v1[0], v1[1]); w.w = cvt_pk_bf16(v1[2], v1[3]);
                        *(u32x4*)(rowp + bj * HALF) = w; } } }
    }
};
struct EpiGate {
    static constexpr bool PERM = false;
    float* xo; const bf16_t* ple; const float* bg;
    __device__ __forceinline__ void operator()(const f32x4 (&acc)[2][2][4][2], const Unit& u, int wr, int wc, int fr, int fq) const {
        const int row0 = u.pm * BM + wr * 64 + fr, col0 = u.pn * BM + wc * 32 + 4 * fq;
        f32x4 bv[2][2];
#pragma unroll
        for (int bj = 0; bj < 2; ++bj)
#pragma unroll
            for (int n = 0; n < 2; ++n) bv[bj][n] = *(const f32x4*)(bg + col0 + bj * HALF + n * 16);
#pragma unroll
        for (int ai = 0; ai < 2; ++ai)
#pragma unroll
            for (int m = 0; m < 4; ++m) { const size_t off = (size_t)(row0 + ai * HALF + m * 16) * D + col0;
#pragma unroll
                for (int bj = 0; bj < 2; ++bj)
#pragma unroll
                    for (int n = 0; n < 2; ++n) { const size_t o = off + bj * HALF + n * 16; const f32x4 xv = *(const f32x4*)(xo + o); const u32x2 pw = *(const u32x2*)(ple + o);
                        const f32x4 z = acc[ai][bj][m][n] + bv[bj][n]; f32x4 r;
                        const float pl[4] = {bf_lo(pw.x), bf_hi(pw.x), bf_lo(pw.y), bf_hi(pw.y)};
#pragma unroll
                        for (int i = 0; i < 4; ++i) { const float sg = __builtin_amdgcn_rcpf(1.0f + __builtin_amdgcn_exp2f(z[i] * -1.4426950408889634f)); r[i] = xv[i] * ALPHA + sg * pl[i]; }
                        *(f32x4*)(xo + o) = r; }
                asm volatile("" ::: "memory"); }
    }
};

template <class Epi, class Sched>
__device__ __forceinline__ void gemm_phase(LAS unsigned char* lds, const int K, const Sched& S, const Epi& E) {
    const int tid = threadIdx.x, wid = __builtin_amdgcn_readfirstlane(tid >> 6), lane = tid & 63, wr = wid >> 2, wc = wid & 3, fr = lane & 15, fq = lane >> 4;
    const int nt = K / BK;
    int R0, C0; stage_rc(tid * 16, R0, C0);
    unsigned voffB[2];
#pragma unroll
    for (int i = 0; i < 2; ++i) { const int R = R0 + 64 * i; const int Rb = Epi::PERM ? ((R & ~31) + perm32(R & 31)) : R; voffB[i] = (unsigned)(Rb * K + C0) * 2u; }
    const unsigned coff = (unsigned)C0 * 2u;
    const size_t kstep = (size_t)(BK * 2);
    const size_t hstep = (size_t)HALF * K * 2;
    const unsigned ldsw = (unsigned)wid * 1024u;
    const int aoff = lds_byte(wr * 64 + fr, fq * 8), boff = lds_byte(wc * 32 + fr, fq * 8);
#define PG8_SA(b, h) (((b) * 2 + (h)) * HTB)
#define PG8_SB(b, h) ((4 + (b) * 2 + (h)) * HTB)
#define PG8_STAGE_B(bufoff, gbase) do { _Pragma("unroll") for (int _i = 0; _i < 2; ++_i) \
        __builtin_amdgcn_global_load_lds((const unsigned*)((const char*)(gbase) + voffB[_i]), (LAS unsigned*)(lds + (bufoff) + ldsw + _i * 8192), 16, 0, 0); } while (0)
#define PG8_STAGE_A(bufoff, gbase, off, h) do { _Pragma("unroll") for (int _i = 0; _i < 2; ++_i) \
        __builtin_amdgcn_global_load_lds((const unsigned*)((const char*)(gbase) + (off)[2 * (h) + _i]), (LAS unsigned*)(lds + (bufoff) + ldsw + _i * 8192), 16, 0, 0); } while (0)
#define PG8_LDA(dst, b, h) do { _Pragma("unroll") for (int m = 0; m < 4; ++m) _Pragma("unroll") for (int k = 0; k < 2; ++k) dst[m][k] = *(const LAS bf16x8*)(lds + PG8_SA(b, h) + aoff + m * 2048 + k * 1024); } while (0)
#define PG8_LDB(dst, b, h) do { _Pragma("unroll") for (int n = 0; n < 2; ++n) _Pragma("unroll") for (int k = 0; k < 2; ++k) dst[n][k] = *(const LAS bf16x8*)(lds + PG8_SB(b, h) + boff + n * 2048 + k * 1024); } while (0)
#define PG8_MMA(ai, bj, At, Bt) do { __builtin_amdgcn_s_setprio(1); _Pragma("unroll") for (int m = 0; m < 4; ++m) _Pragma("unroll") for (int n = 0; n < 2; ++n) _Pragma("unroll") for (int k = 0; k < 2; ++k) \
        acc[ai][bj][m][n] = __builtin_amdgcn_mfma_f32_16x16x32_bf16(Bt[n][k], At[m][k], acc[ai][bj][m][n], 0, 0, 0); __builtin_amdgcn_s_setprio(0); } while (0)
#define PG8_WAIT_V(n) asm volatile("s_waitcnt vmcnt(" #n ")" ::: "memory")
#define PG8_WAIT_L(n) asm volatile("s_waitcnt lgkmcnt(" #n ")" ::: "memory")
#define PG8_BAR __builtin_amdgcn_s_barrier()
#define PG8_SCHED __builtin_amdgcn_sched_barrier(0)
#define PG8_PIN4(o) asm volatile("" : "+v"((o)[0]), "+v"((o)[1]), "+v"((o)[2]), "+v"((o)[3]))
    Unit cur, nxt, nn; int ui = 0;
    if (!S.next(0, cur)) return;
    bool has_next = S.next(1, nxt);
    unsigned offc[4], offn[4], offnn[4];
    S.rows(cur, R0, offc);
    if (has_next) S.rows(nxt, R0, offn); else { _Pragma("unroll") for (int j = 0; j < 4; ++j) offn[j] = offc[j]; }
#pragma unroll
    for (int j = 0; j < 4; ++j) { offc[j] += coff; if (has_next) offn[j] += coff; else offn[j] = offc[j]; }
    if constexpr (Sched::GATHER) { PG8_PIN4(offc); PG8_PIN4(offn); }
    f32x4 acc[2][2][4][2];
#pragma unroll
    for (int a = 0; a < 2; ++a)
#pragma unroll
        for (int b = 0; b < 2; ++b)
#pragma unroll
            for (int m = 0; m < 4; ++m)
#pragma unroll
                for (int n = 0; n < 2; ++n) acc[a][b][m][n] = (f32x4){0.f, 0.f, 0.f, 0.f};
    bf16x8 At[4][2], B0[2][2], B1[2][2];
    const char* cA = cur.A; const char* cB = cur.B;
    PG8_STAGE_B(PG8_SB(0, 0), cB); PG8_STAGE_B(PG8_SB(0, 1), cB + hstep); PG8_STAGE_A(PG8_SA(0, 0), cA, offc, 0); PG8_STAGE_A(PG8_SA(0, 1), cA, offc, 1);
    if (wr == 1) PG8_BAR;
    PG8_WAIT_V(2); PG8_BAR;
    PG8_STAGE_B(PG8_SB(1, 0), cB + kstep); PG8_STAGE_A(PG8_SA(1, 0), cA + kstep, offc, 0); PG8_STAGE_B(PG8_SB(1, 1), cB + hstep + kstep);
    PG8_WAIT_V(6); PG8_BAR;
    for (;;) {
        const char* nA = has_next ? nxt.A : cA; const char* nB = has_next ? nxt.B : cB;
        for (int t = 0; t < nt; t += 2) {
            const bool last = (t == nt - 2);
            const char* a1 = cA + (size_t)(t + 1) * kstep;
            const char* a2 = last ? nA : cA + (size_t)(t + 2) * kstep; const char* b2 = last ? nB : cB + (size_t)(t + 2) * kstep;
            const char* a3 = a2 + kstep; const char* b3 = b2 + kstep;
            unsigned o2[4];
#pragma unroll
            for (int j = 0; j < 4; ++j) o2[j] = last ? offn[j] : offc[j];
            PG8_LDB(B0, 0, 0); PG8_LDB(B1, 0, 1); PG8_SCHED; PG8_LDA(At, 0, 0); PG8_STAGE_A(PG8_SA(1, 1), a1, offc, 1);
            PG8_WAIT_V(8); PG8_WAIT_L(0); PG8_BAR; PG8_MMA(0, 0, At, B0); PG8_MMA(0, 1, At, B1); PG8_BAR; PG8_SCHED;
            PG8_LDA(At, 0, 1); PG8_STAGE_B(PG8_SB(0, 0), b2); PG8_STAGE_B(PG8_SB(0, 1), b2 + hstep); PG8_STAGE_A(PG8_SA(0, 0), a2, o2, 0);
            PG8_WAIT_V(8); PG8_WAIT_L(0); PG8_BAR; PG8_MMA(1, 0, At, B0); PG8_MMA(1, 1, At, B1); PG8_BAR; PG8_SCHED;
            PG8_LDB(B0, 1, 0); PG8_LDB(B1, 1, 1); PG8_SCHED; PG8_LDA(At, 1, 0); PG8_STAGE_A(PG8_SA(0, 1), a2, o2, 1);
            PG8_WAIT_V(8); PG8_WAIT_L(0); PG8_BAR; PG8_MMA(0, 0, At, B0); PG8_MMA(0, 1, At, B1); PG8_BAR; PG8_SCHED;
            PG8_LDA(At, 1, 1); PG8_STAGE_B(PG8_SB(1, 0), b3); PG8_STAGE_B(PG8_SB(1, 1), b3 + hstep); PG8_STAGE_A(PG8_SA(1, 0), a3, o2, 0);
            PG8_WAIT_V(8); PG8_WAIT_L(0); PG8_BAR; PG8_MMA(1, 0, At, B0); PG8_MMA(1, 1, At, B1); PG8_BAR; PG8_SCHED;
        }
        if (wr == 0) PG8_BAR;
        bool has2 = false;
        if (has_next) { has2 = S.next(ui + 2, nn); if (has2) { S.rows(nn, R0, offnn); } }
        E(acc, cur, wr, wc, fr, fq);
        if (!has_next) break;
#pragma unroll
        for (int a = 0; a < 2; ++a)
#pragma unroll
            for (int b = 0; b < 2; ++b)
#pragma unroll
                for (int m = 0; m < 4; ++m)
#pragma unroll
                    for (int n = 0; n < 2; ++n) acc[a][b][m][n] = (f32x4){0.f, 0.f, 0.f, 0.f};
        cur = nxt; cA = nA; cB = nB; ++ui;
#pragma unroll
        for (int j = 0; j < 4; ++j) { offc[j] = offn[j]; if (has2) offn[j] = offnn[j] + coff; }
        if (has2) nxt = nn;
        has_next = has2;
        if constexpr (Sched::GATHER) { PG8_PIN4(offn); }
        if (wr == 1) PG8_BAR;
    }
    PG8_WAIT_V(0);
    PG8_BAR;
#undef PG8_SA
#undef PG8_SB
#undef PG8_STAGE_A
#undef PG8_STAGE_B
#undef PG8_LDA
#undef PG8_LDB
#undef PG8_MMA
#undef PG8_WAIT_V
#undef PG8_WAIT_L
#undef PG8_BAR
#undef PG8_SCHED
#undef PG8_PIN4
}
}

#define XB_TMO      128
#define XB_XCNT(j)  (256  + 64 * (j))
#define XB_XSUB(j)  (1280 + 64 * (j))
#define XB_XGEN(j)  (2304 + 64 * (j))
#define XB_TOP      3328
#define XB_TOPGEN   3392
#define XCD_BAR_WORDS 3456
#define XB_SPIN_CAP (1u << 18)
__device__ __forceinline__ unsigned xb_ld(unsigned* p)              { return __hip_atomic_load(p, __ATOMIC_RELAXED, __HIP_MEMORY_SCOPE_AGENT); }
__device__ __forceinline__ unsigned xb_add(unsigned* p, unsigned v) { return __hip_atomic_fetch_add(p, v, __ATOMIC_RELAXED, __HIP_MEMORY_SCOPE_AGENT); }
__device__ __forceinline__ unsigned xb_xcc_id() { return (unsigned)__builtin_amdgcn_s_getreg((3 << 11) | 20) & 0xFu; }
#define XB_SPIN(cond, bar) do { unsigned _sp = 0; while (cond) { __builtin_amdgcn_s_sleep(1); \
    if ((++_sp & 255u) == 0u) { if (xb_ld(&(bar)[XB_TMO])) break; if (_sp > XB_SPIN_CAP) { atomicAdd(&(bar)[XB_TMO], 1u); break; } } } } while (0)
struct XcdBarrier { unsigned* bar; unsigned x; volatile LAS unsigned* st; };
__device__ __forceinline__ XcdBarrier xcd_barrier_post(unsigned* bar, volatile LAS unsigned* st) {
    XcdBarrier b; b.bar = bar; b.x = xb_xcc_id(); b.st = st;
    if (threadIdx.x == 0) (void)xb_add(&bar[XB_XCNT(b.x)], 1u);
    return b;
}
__device__ __forceinline__ void xcd_barrier_complete(unsigned* bar, unsigned x, unsigned& nloc, unsigned& nx) {
    const unsigned G = gridDim.x * gridDim.y * gridDim.z;
    unsigned sum, cnt, mine, sp = 0u;
    for (;;) {
        sum = 0u; cnt = 0u; mine = 0u;
#pragma unroll
        for (unsigned j = 0; j < 16; ++j) { const unsigned c = xb_ld(&bar[XB_XCNT(j)]); sum += c; cnt += (c > 0u) ? 1u : 0u; mine = (j == x) ? c : mine; }
        if (sum == G) break;
        __builtin_amdgcn_s_sleep(1);
        if ((++sp & 255u) == 0u) { if (xb_ld(&bar[XB_TMO])) break; if (sp > XB_SPIN_CAP) { atomicAdd(&bar[XB_TMO], 1u); break; } }
    }
    nloc = mine > 0u ? mine : 1u; nx = cnt > 0u ? cnt : 1u;
}
__device__ __forceinline__ void xcd_barrier(const XcdBarrier& b) {
    asm volatile("s_waitcnt vmcnt(0)" ::: "memory");
    __syncthreads();
    if (threadIdx.x == 0) {
        unsigned* bar = b.bar;
        __builtin_amdgcn_s_waitcnt(0);
        unsigned nloc = b.st[0], nx = b.st[1];
        if (nloc == 0u) { xcd_barrier_complete(bar, b.x, nloc, nx); b.st[0] = nloc; b.st[1] = nx; }
        const unsigned old = xb_add(&bar[XB_XSUB(b.x)], 1u);
        const unsigned gen = old / nloc;
        if (old + 1u == (gen + 1u) * nloc) {
            __builtin_amdgcn_fence(__ATOMIC_RELEASE, "agent");
            asm volatile("s_waitcnt vmcnt(0)" ::: "memory");
            const unsigned og = xb_add(&bar[XB_TOP], 1u);
            const unsigned tg = og / nx;
            if (og + 1u == (tg + 1u) * nx) xb_add(&bar[XB_TOPGEN], 1u);
            else XB_SPIN(xb_ld(&bar[XB_TOPGEN]) == tg, bar);
            __builtin_amdgcn_fence(__ATOMIC_ACQUIRE, "agent");
            xb_add(&bar[XB_XGEN(b.x)], 1u);
            asm volatile("s_waitcnt vmcnt(0)" ::: "memory");
        } else {
            XB_SPIN(xb_ld(&bar[XB_XGEN(b.x)]) == gen, bar);
            __builtin_amdgcn_fence(__ATOMIC_ACQUIRE, "agent");
            asm volatile("s_waitcnt vmcnt(0)" ::: "memory");
        }
    }
    __syncthreads();
}

struct Args {
    const float* x; const float* p; const float* w_in; const float* pool_mix; const float* pool_scale; const float* conv_w; const float* w_out;
    const float* ln1_g; const float* ln1_b; const float* router_w; const float* router_b; const float* w_gu; const float* b_gu; const float* w_dn; const float* b_dn;
    const float* ln2_g; const float* ln2_b; const float* ple_proj; const float* ple_gate_w; const float* ple_gate_b; const float* ln3_g; const float* ln3_b;
    float* out; unsigned char* ws; int ph_lo, ph_hi;
};
struct Frame { LAS unsigned char* lds; int tid, lane, wave, vcu, G; };

__device__ __forceinline__ void tr_item(const float* src, int ld_src, bf16_t* dst, int ld_dst, LAS float* scr, int lane) {
    const int kr = lane >> 3, nq = lane & 7;
    f32x4 v[8];
#pragma unroll
    for (int r = 0; r < 8; ++r) v[r] = *(const f32x4*)(src + (size_t)(8 * r + kr) * ld_src + 4 * nq);
#pragma unroll
    for (int r = 0; r < 8; ++r)
#pragma unroll
        for (int q = 0; q < 4; ++q) scr[(8 * r + kr) * 33 + 4 * nq + q] = v[r][q];
    LDS_WAIT(); asm volatile("" ::: "memory");
    const int c = lane & 7;
#pragma unroll
    for (int j = 0; j < 4; ++j) { const int n = (lane >> 3) + 8 * j; const LAS float* s = scr + (8 * c) * 33 + n;
        u32x4 o; o.x = cvt_pk_bf16(s[0 * 33], s[1 * 33]); o.y = cvt_pk_bf16(s[2 * 33], s[3 * 33]); o.z = cvt_pk_bf16(s[4 * 33], s[5 * 33]); o.w = cvt_pk_bf16(s[6 * 33], s[7 * 33]);
        *(u32x4*)(dst + (size_t)n * ld_dst + 8 * c) = o; }
    LDS_WAIT(); asm volatile("" ::: "memory");
}
__device__ __forceinline__ void fold_item(const Args& a, bf16_t* W2T, LAS float* scr, int item, int lane) {
    const int g = item >> 8, cb = (item >> 4) & 15, nb = item & 15, c0 = cb * 8, n = nb * 64 + lane;
#pragma unroll
    for (int i = 0; i < 16; ++i) { const int idx = i * 64 + lane, c = idx >> 7, d = idx & 127; scr[d * 8 + c] = a.pool_mix[(size_t)(g * 128 + c0 + c) * 128 + d]; }
    LDS_WAIT(); asm volatile("" ::: "memory");
    float acc[8];
#pragma unroll
    for (int c = 0; c < 8; ++c) acc[c] = 0.f;
#pragma unroll 4
    for (int d = 0; d < 128; ++d) {
        const float wv = a.w_out[(size_t)(g * 128 + d) * D + n] * a.pool_scale[g * 128 + d];
        const f32x4 p0 = *(const LAS f32x4*)(scr + d * 8), p1 = *(const LAS f32x4*)(scr + d * 8 + 4);
        acc[0] += p0[0] * wv; acc[1] += p0[1] * wv; acc[2] += p0[2] * wv; acc[3] += p0[3] * wv;
        acc[4] += p1[0] * wv; acc[5] += p1[1] * wv; acc[6] += p1[2] * wv; acc[7] += p1[3] * wv;
    }
    u32x4 o; o.x = cvt_pk_bf16(acc[0], acc[1]); o.y = cvt_pk_bf16(acc[2], acc[3]); o.z = cvt_pk_bf16(acc[4], acc[5]); o.w = cvt_pk_bf16(acc[6], acc[7]);
    *(u32x4*)(W2T + (size_t)n * D + g * 128 + c0) = o;
    LDS_WAIT(); asm volatile("" ::: "memory");
}
__device__ __forceinline__ void p0_prologue(const Frame& F, const Args& a) {
    unsigned char* ws = a.ws;
    LAS float* scr = (LAS float*)(F.lds + F.wave * 16384);
    const int gw = F.vcu * 8 + F.wave, NGW = F.G * 8;
    bf16_t* WinT = (bf16_t*)(ws + WS_WIN); bf16_t* W2T = (bf16_t*)(ws + WS_W2); bf16_t* WgT = (bf16_t*)(ws + WS_WG); bf16_t* WpT = (bf16_t*)(ws + WS_WP);
    bf16_t* WguT = (bf16_t*)(ws + WS_WGU); bf16_t* WdnT = (bf16_t*)(ws + WS_WDN);
    constexpr int I_FOLD = 1024, I_IN = 16 * 64, I_OUT = 8 * 32, I_G = 16 * 32, I_P = 4 * 32, I_GU = NE * 16 * 64, I_DN = NE * 16 * 32;
    constexpr int NITEMS = I_FOLD + I_IN + I_OUT + I_G + I_P + I_GU + I_DN;
    for (int it = gw; it < NITEMS; it += NGW) {
        int r = it;
        if (r < I_FOLD) { fold_item(a, W2T, scr, r, F.lane); continue; } r -= I_FOLD;
        if (r < I_IN) { const int kb = r >> 6, nb = r & 63; tr_item(a.w_in + (size_t)(64 * kb) * DIN + 32 * nb, DIN, WinT + (size_t)(32 * nb) * D + 64 * kb, D, scr, F.lane); continue; } r -= I_IN;
        if (r < I_OUT) { const int kb = r >> 5, nb = r & 31; tr_item(a.w_out + (size_t)(DPOOL + 64 * kb) * D + 32 * nb, D, W2T + (size_t)(32 * nb) * D + DPOOL + 64 * kb, D, scr, F.lane); continue; } r -= I_OUT;
        if (r < I_G) { const int kb = r >> 5, nb = r & 31; tr_item(a.ple_gate_w + (size_t)(64 * kb) * D + 32 * nb, D, WgT + (size_t)(32 * nb) * D + 64 * kb, D, scr, F.lane); continue; } r -= I_G;
        if (r < I_P) { const int kb = r >> 5, nb = r & 31; tr_item(a.ple_proj + (size_t)(64 * kb) * D + 32 * nb, D, WpT + (size_t)(32 * nb) * PLE + 64 * kb, PLE, scr, F.lane); continue; } r -= I_P;
        if (r < I_GU) { const int e = r >> 10, q = r & 1023, kb = q >> 6, nb = q & 63, n0 = 32 * nb;
            const int h = n0 >> 10, j = n0 & 1023, drow = (j >> 7) * 256 + h * 128 + (j & 127);
            tr_item(a.w_gu + ((size_t)e * D + 64 * kb) * (2 * FF) + n0, 2 * FF, WguT + ((size_t)e * (2 * FF) + drow) * D + 64 * kb, D, scr, F.lane); continue; } r -= I_GU;
        { const int e = r >> 9, q = r & 511, kb = q >> 5, nb = q & 31;
            tr_item(a.w_dn + ((size_t)e * FF + 64 * kb) * D + 32 * nb, D, WdnT + ((size_t)e * D + 32 * nb) * FF + 64 * kb, FF, scr, F.lane); }
    }
    const size_t gt = (size_t)F.vcu * 512 + F.tid, NT = (size_t)F.G * 512;
    { const f32x4* s = (const f32x4*)a.x; u32x4* d = (u32x4*)(ws + WS_XB);
        for (size_t i = gt; i < (size_t)M * D / 8; i += NT) { const f32x4 v0 = s[2 * i], v1 = s[2 * i + 1]; u32x4 o; o.x = cvt_pk_bf16(v0[0], v0[1]); o.y = cvt_pk_bf16(v0[2], v0[3]); o.z = cvt_pk_bf16(v1[0], v1[1]); o.w = cvt_pk_bf16(v1[2], v1[3]); d[i] = o; } }
    { const f32x4* s = (const f32x4*)a.p; u32x4* d = (u32x4*)(ws + WS_PB);
        for (size_t i = gt; i < (size_t)M * PLE / 8; i += NT) { const f32x4 v0 = s[2 * i], v1 = s[2 * i + 1]; u32x4 o; o.x = cvt_pk_bf16(v0[0], v0[1]); o.y = cvt_pk_bf16(v0[2], v0[3]); o.z = cvt_pk_bf16(v1[0], v1[1]); o.w = cvt_pk_bf16(v1[2], v1[3]); d[i] = o; } }
}

__device__ __forceinline__ void unpack8(const u32x4 w, float (&f)[8]) { f[0] = bf_lo(w.x); f[1] = bf_hi(w.x); f[2] = bf_lo(w.y); f[3] = bf_hi(w.y); f[4] = bf_lo(w.z); f[5] = bf_hi(w.z); f[6] = bf_lo(w.w); f[7] = bf_hi(w.w); }
__device__ __forceinline__ void p2_mixer(const Frame& F, const Args& a) {
    const bf16_t* proj = (const bf16_t*)(a.ws + WS_PROJ); bf16_t* A2 = (bf16_t*)(a.ws + WS_A2);
    const int gw = F.vcu * 8 + F.wave, NGW = F.G * 8, c = 8 * F.lane;
    const int win = 2 << (F.lane >> 4);
    float cw[3][8];
#pragma unroll
    for (int k = 0; k < 3; ++k)
#pragma unroll
        for (int i = 0; i < 8; ++i) cw[k][i] = a.conv_w[k * DPOOL + c + i];
    for (int it = gw; it < (M / 16) * 2; it += NGW) {
        const int half = it & 1, t0 = (it >> 1) * 16;
        if (half == 0) {
            for (int tt = 0; tt < 16; ++tt) { const int t = t0 + tt, s = t & (SEQ - 1); const int nwin = (s + 1 < win) ? s + 1 : win;
                float acc[8], vt[8];
#pragma unroll
                for (int i = 0; i < 8; ++i) acc[i] = 0.f;
#pragma unroll
                for (int d = 0; d < 16; ++d) { if (d < nwin) { const u32x4 w = *(const u32x4*)(proj + (size_t)(t - d) * DIN + c); float f[8]; unpack8(w, f);
#pragma unroll
                        for (int i = 0; i < 8; ++i) { acc[i] += f[i]; if (d == 0) vt[i] = f[i]; } } }
                const float inv = 1.0f / (float)nwin; float o[8];
#pragma unroll
                for (int i = 0; i < 8; ++i) o[i] = acc[i] * inv - vt[i];
                u32x4 w; w.x = cvt_pk_bf16(o[0], o[1]); w.y = cvt_pk_bf16(o[2], o[3]); w.z = cvt_pk_bf16(o[4], o[5]); w.w = cvt_pk_bf16(o[6], o[7]);
                *(u32x4*)(A2 + (size_t)t * D + c) = w; }
        } else {
            for (int tt = 0; tt < 16; ++tt) { const int t = t0 + tt, s = t & (SEQ - 1);
                float y[8];
#pragma unroll
                for (int i = 0; i < 8; ++i) y[i] = 0.f;
#pragma unroll
                for (int k = 0; k < 3; ++k) { const int dlt = 2 - k; if (s - dlt >= 0) { const bf16_t* rp = proj + (size_t)(t - dlt) * DIN + c;
                        const u32x4 wc_ = *(const u32x4*)(rp + 1024), wv_ = *(const u32x4*)(rp + 1536); float fc[8], fv[8]; unpack8(wc_, fc); unpack8(wv_, fv);
#pragma unroll
                        for (int i = 0; i < 8; ++i) y[i] += cw[k][i] * (fc[i] * fv[i]); } }
                const u32x4 wb = *(const u32x4*)(proj + (size_t)t * DIN + 512 + c); float fb[8]; unpack8(wb, fb);
#pragma unroll
                for (int i = 0; i < 8; ++i) y[i] *= fb[i];
                u32x4 w; w.x = cvt_pk_bf16(y[0], y[1]); w.y = cvt_pk_bf16(y[2], y[3]); w.z = cvt_pk_bf16(y[4], y[5]); w.w = cvt_pk_bf16(y[6], y[7]);
                *(u32x4*)(A2 + (size_t)t * D + DPOOL + c) = w; }
        }
    }
}

__device__ __forceinline__ void load_row16(const float* rp, int lane, float (&v)[16]) {
#pragma unroll
    for (int j = 0; j < 2; ++j) { const f32x4 a0 = *(const f32x4*)(rp + 8 * lane + 512 * j), a1 = *(const f32x4*)(rp + 8 * lane + 512 * j + 4);
#pragma unroll
        for (int i = 0; i < 4; ++i) { v[8 * j + i] = a0[i]; v[8 * j + 4 + i] = a1[i]; } }
}
__device__ __forceinline__ void store_row16(float* rp, int lane, const float (&v)[16]) {
#pragma unroll
    for (int j = 0; j < 2; ++j) { *(f32x4*)(rp + 8 * lane + 512 * j) = (f32x4){v[8 * j], v[8 * j + 1], v[8 * j + 2], v[8 * j + 3]}; *(f32x4*)(rp + 8 * lane + 512 * j + 4) = (f32x4){v[8 * j + 4], v[8 * j + 5], v[8 * j + 6], v[8 * j + 7]}; }
}
__device__ __forceinline__ void ln_row16(float (&v)[16], const float (&g)[16], const float (&b)[16]) {
    float s = 0.f;
#pragma unroll
    for (int i = 0; i < 16; ++i) s += v[i];
    const float mean = wave_sum(s) * (1.0f / D); float q = 0.f;
#pragma unroll
    for (int i = 0; i < 16; ++i) { v[i] -= mean; q += v[i] * v[i]; }
    const float rstd = 1.0f / sqrtf(wave_sum(q) * (1.0f / D) + LN_EPS);
#pragma unroll
    for (int i = 0; i < 16; ++i) v[i] = v[i] * rstd * g[i] + b[i];
}

constexpr int XPITCH = 2064;
constexpr int L_XHI = 0, L_XLO = 16 * XPITCH, L_PART = 2 * 16 * XPITCH  ;
__device__ __forceinline__ void p4_ln1_router(const Frame& F, const Args& a) {
    float* R = a.out; bf16_t* X1B = (bf16_t*)(a.ws + WS_XB1); float* TG = (float*)(a.ws + WS_TG); int* LIST = (int*)(a.ws + WS_LIST);
    unsigned* gcnt = (unsigned*)(a.ws + WS_CTL) + CW_CNT;
    LAS unsigned* lhist = (LAS unsigned*)(F.lds + L_HIST); LAS unsigned* lbase = (LAS unsigned*)(F.lds + L_BASE); LAS unsigned* asg = (LAS unsigned*)(F.lds + L_ASG);
    const int lane = F.lane, w = F.wave, fr = lane & 15, fq = lane >> 4;
    if (F.tid < 32) lhist[F.tid] = 0u;
    float g[16], b[16];
    load_row16(a.ln1_g, lane, g); load_row16(a.ln1_b, lane, b);
    bf16x8 bhi[4][2], blo[4][2];
#pragma unroll
    for (int ks = 0; ks < 4; ++ks)
#pragma unroll
        for (int h = 0; h < 2; ++h) { unsigned hw[4], lw[4];
#pragma unroll
            for (int i2 = 0; i2 < 4; ++i2) { const int k = 128 * w + 32 * ks + 8 * fq + 2 * i2; const float v0 = a.router_w[(size_t)k * NE + 16 * h + fr], v1 = a.router_w[(size_t)(k + 1) * NE + 16 * h + fr];
                const unsigned hp = cvt_pk_bf16(v0, v1); const float r0 = v0 - bf_lo(hp), r1 = v1 - bf_hi(hp); hw[i2] = hp; lw[i2] = cvt_pk_bf16(r0, r1); }
            bhi[ks][h] = __builtin_bit_cast(bf16x8, (u32x4){hw[0], hw[1], hw[2], hw[3]}); blo[ks][h] = __builtin_bit_cast(bf16x8, (u32x4){lw[0], lw[1], lw[2], lw[3]}); }
    const float rbias = a.router_b[F.tid & 31];
    __syncthreads();
    int gl = 0;
    for (int grp = F.vcu; grp < M / 16; grp += F.G, ++gl) {
        const int row0 = grp * 16;
#pragma unroll
        for (int rr = 0; rr < 2; ++rr) { const int rl = 2 * w + rr; float* rp = R + (size_t)(row0 + rl) * D; float v[16];
            load_row16(rp, lane, v); ln_row16(v, g, b); store_row16(rp, lane, v);
#pragma unroll
            for (int j = 0; j < 2; ++j) { unsigned hw[4], lw[4];
#pragma unroll
                for (int i2 = 0; i2 < 4; ++i2) { const float v0 = v[8 * j + 2 * i2], v1 = v[8 * j + 2 * i2 + 1]; const unsigned hp = cvt_pk_bf16(v0, v1); hw[i2] = hp; lw[i2] = cvt_pk_bf16(v0 - bf_lo(hp), v1 - bf_hi(hp)); }
                const u32x4 hv = {hw[0], hw[1], hw[2], hw[3]}, lv = {lw[0], lw[1], lw[2], lw[3]};
                *(u32x4*)(X1B + (size_t)(row0 + rl) * D + 8 * lane + 512 * j) = hv;
                *(LAS u32x4*)(F.lds + L_XHI + rl * XPITCH + (8 * lane + 512 * j) * 2) = hv; *(LAS u32x4*)(F.lds + L_XLO + rl * XPITCH + (8 * lane + 512 * j) * 2) = lv; } }
        __syncthreads();
        f32x4 acc[2] = {(f32x4){0.f, 0.f, 0.f, 0.f}, (f32x4){0.f, 0.f, 0.f, 0.f}};
#pragma unroll
        for (int ks = 0; ks < 4; ++ks) { const int ko = (128 * w + 32 * ks + 8 * fq) * 2;
            const bf16x8 ahi = *(const LAS bf16x8*)(F.lds + L_XHI + fr * XPITCH + ko), alo = *(const LAS bf16x8*)(F.lds + L_XLO + fr * XPITCH + ko);
#pragma unroll
            for (int h = 0; h < 2; ++h) { acc[h] = __builtin_amdgcn_mfma_f32_16x16x32_bf16(bhi[ks][h], ahi, acc[h], 0, 0, 0); acc[h] = __builtin_amdgcn_mfma_f32_16x16x32_bf16(blo[ks][h], ahi, acc[h], 0, 0, 0);
                acc[h] = __builtin_amdgcn_mfma_f32_16x16x32_bf16(bhi[ks][h], alo, acc[h], 0, 0, 0); } }
#pragma unroll
        for (int h = 0; h < 2; ++h) *(LAS f32x4*)(F.lds + L_PART + ((w * 16 + fr) * 32 + 16 * h + 4 * fq) * 4) = acc[h];
        __syncthreads();
        { const int rl = F.tid >> 5, e = F.tid & 31; float v = rbias;
#pragma unroll
            for (int ww = 0; ww < 8; ++ww) v += *(const LAS float*)(F.lds + L_PART + ((ww * 16 + rl) * 32 + e) * 4);
            bool taken = false; float sv[4]; int si[4];
#pragma unroll
            for (int r = 0; r < 4; ++r) { float bv = taken ? -__builtin_inff() : v; int bi = e;
#pragma unroll
                for (int mk = 1; mk < 32; mk <<= 1) { const float ov = __shfl_xor(bv, mk); const int oi = __shfl_xor(bi, mk); if (ov > bv || (ov == bv && oi < bi)) { bv = ov; bi = oi; } }
                sv[r] = bv; si[r] = bi; if (bi == e) taken = true; }
            const float p1 = __expf(sv[1] - sv[0]), p2 = __expf(sv[2] - sv[0]), p3 = __expf(sv[3] - sv[0]); const float inv = 1.0f / (1.0f + p1 + p2 + p3);
            if (e < 4) { const float gk = (e == 0 ? 1.0f : e == 1 ? p1 : e == 2 ? p2 : p3) * inv; const int ek = e == 0 ? si[0] : e == 1 ? si[1] : e == 2 ? si[2] : si[3];
                TG[(size_t)(row0 + rl) * 4 + e] = gk;
                const unsigned rank = atomicAdd((unsigned*)(lhist + ek), 1u);
                asg[(gl * 16 + rl) * 4 + e] = ((unsigned)ek << 16) | rank; } }
    }
    __syncthreads();
    if (F.tid < 32) lbase[F.tid] = __hip_atomic_fetch_add(gcnt + F.tid, lhist[F.tid], RLX_AGENT);
    __syncthreads();
    for (int s = F.tid; s < gl * 64; s += 512) { const unsigned av = asg[s]; const int e = av >> 16, rank = av & 0xffff; const int g2 = s >> 6, rl = (s >> 2) & 15, k = s & 3;
        const int tok = (F.vcu + g2 * F.G) * 16 + rl; LIST[(size_t)e * LCAP + lbase[e] + rank] = tok * 4 + k; }
}

__device__ __forceinline__ void moe_tables(const Frame& F, const Args& a, int ncol  ) {
    LAS int* tst = (LAS int*)(F.lds + L_TST); LAS int* lcnt = (LAS int*)(F.lds + L_CNT); LAS int* ut = (LAS int*)(F.lds + L_UT);
    unsigned* gcnt = (unsigned*)(a.ws + WS_CTL) + CW_CNT;
    if (F.tid < 32) lcnt[F.tid] = (int)__hip_atomic_load(gcnt + F.tid, RLX_AGENT);
    __syncthreads();
    if (F.tid == 0) { int s = 0; for (int e = 0; e < NE; ++e) { tst[e] = s; s += (lcnt[e] + 255) >> 8; } tst[NE] = s; }
    __syncthreads();
    if (F.tid < 32) { const int i = F.tid; const int T = tst[NE]; const long L = (long)i * F.G + F.vcu; int e = 0, tile = 0, pn = 0, valid = 0, lb = 0, nv = 0;
        if (L < (long)T * ncol) { tile = (int)(L / ncol); pn = (int)(L % ncol); valid = 1; for (int q = 0; q < NE; ++q) if (tst[q + 1] <= tile) e = q + 1;
            const int tin = tile - tst[e]; lb = e * LCAP + tin * 256; nv = lcnt[e] - tin * 256; nv = nv > 256 ? 256 : nv; }
        ut[i * 8 + 0] = e; ut[i * 8 + 1] = tile; ut[i * 8 + 2] = pn; ut[i * 8 + 3] = valid; ut[i * 8 + 4] = lb; ut[i * 8 + 5] = nv; ut[i * 8 + 6] = 0; ut[i * 8 + 7] = 0; }
    __syncthreads();
}

__device__ __forceinline__ void p7_combine_ln2(const Frame& F, const Args& a) {
    float* R = a.out; bf16_t* X2B = (bf16_t*)(a.ws + WS_XB1); const float* TG = (const float*)(a.ws + WS_TG); const bf16_t* Y = (const bf16_t*)(a.ws + WS_Y);
    const int lane = F.lane, gw = F.vcu * 8 + F.wave, NGW = F.G * 8;
    float g[16], b[16]; load_row16(a.ln2_g, lane, g); load_row16(a.ln2_b, lane, b);
    for (int row = gw; row < M; row += NGW) { float* rp = R + (size_t)row * D; float v[16]; load_row16(rp, lane, v);
        const f32x4 gt = *(const f32x4*)(TG + (size_t)row * 4);
#pragma unroll
        for (int i = 0; i < 16; ++i) v[i] *= ALPHA;
#pragma unroll
        for (int k = 0; k < 4; ++k) { const bf16_t* yp = Y + ((size_t)row * 4 + k) * D + 8 * lane;
#pragma unroll
            for (int j = 0; j < 2; ++j) { const u32x4 w = *(const u32x4*)(yp + 512 * j); float f[8]; unpack8(w, f);
#pragma unroll
                for (int i = 0; i < 8; ++i) v[8 * j + i] += gt[k] * f[i]; } }
        ln_row16(v, g, b); store_row16(rp, lane, v);
#pragma unroll
        for (int j = 0; j < 2; ++j) { u32x4 o; o.x = cvt_pk_bf16(v[8 * j], v[8 * j + 1]); o.y = cvt_pk_bf16(v[8 * j + 2], v[8 * j + 3]); o.z = cvt_pk_bf16(v[8 * j + 4], v[8 * j + 5]); o.w = cvt_pk_bf16(v[8 * j + 6], v[8 * j + 7]);
            *(u32x4*)(X2B + (size_t)row * D + 8 * lane + 512 * j) = o; } }
}
__device__ __forceinline__ void p9_ln3(const Frame& F, const Args& a) {
    float* R = a.out; const int lane = F.lane, gw = F.vcu * 8 + F.wave, NGW = F.G * 8;
    float g[16], b[16]; load_row16(a.ln3_g, lane, g); load_row16(a.ln3_b, lane, b);
    for (int row = gw; row < M; row += NGW) { float* rp = R + (size_t)row * D; float v[16]; load_row16(rp, lane, v); ln_row16(v, g, b); store_row16(rp, lane, v); }
}

__global__ void __launch_bounds__(512, 2) fwd_kernel(Args args) {
    extern __shared__ __attribute__((aligned(16))) unsigned char lds_raw[];
    Frame F;
    F.lds = (LAS unsigned char*)lds_raw;
    F.tid = threadIdx.x; F.lane = F.tid & 63; F.wave = __builtin_amdgcn_readfirstlane(F.tid >> 6);
    F.G = gridDim.x; { const int bx = blockIdx.x; F.vcu = (F.G % 8 == 0) ? (bx % 8) * (F.G / 8) + bx / 8 : bx; }
    unsigned char* ws = args.ws;
    volatile LAS unsigned* MISC = (volatile LAS unsigned*)(F.lds + L_MISC);
    for (int u = F.tid; u < (LDS_BYTES - RING_BYTES) / 4; u += 512) ((LAS unsigned*)(F.lds + RING_BYTES))[u] = 0u;
    __syncthreads();
    XcdBarrier bar; bar.bar = (unsigned*)(ws + WS_CTL) + CW_BAR; bar.x = 0; bar.st = nullptr;
    if (MK_N_LAUNCHES == 1) bar = xcd_barrier_post((unsigned*)(ws + WS_CTL) + CW_BAR, MISC + 8);
    const int lo = args.ph_lo, hi = args.ph_hi;
#define IN(k) (lo <= (k) && (k) < hi)
#define GRID_BAR(k) do { if (IN(k) && IN((k) + 1)) xcd_barrier(bar); } while (0)

    if (IN(0)) { p0_prologue(F, args); GRID_BAR(0); }

    if (IN(1)) {
        { pg8::DenseOrder S; S.init(ws + WS_XB, ws + WS_WIN, M, DIN, D, F.G, (int)blockIdx.x); pg8::EpiBf16 E{(bf16_t*)(ws + WS_PROJ), DIN};
          pg8::gemm_phase<pg8::EpiBf16, pg8::DenseOrder>(F.lds, D, S, E); }
        { pg8::DenseOrder S; S.init(ws + WS_PB, ws + WS_WP, M, D, PLE, F.G, (int)blockIdx.x); pg8::EpiBf16 E{(bf16_t*)(ws + WS_PLE), D};
          pg8::gemm_phase<pg8::EpiBf16, pg8::DenseOrder>(F.lds, PLE, S, E); }
        GRID_BAR(1);
    }

    if (IN(2)) { p2_mixer(F, args); GRID_BAR(2); }

    if (IN(3)) {
        pg8::DenseOrder S; S.init(ws + WS_A2, ws + WS_W2, M, D, D, F.G, (int)blockIdx.x); pg8::EpiH1 E{args.x, args.out};
        pg8::gemm_phase<pg8::EpiH1, pg8::DenseOrder>(F.lds, D, S, E);
        GRID_BAR(3);
    }

    if (IN(4)) { p4_ln1_router(F, args); GRID_BAR(4); }

    if (IN(5)) {
        moe_tables(F, args, 8);
        pg8::MoeGuOrder S; S.ut = (const LAS int*)(F.lds + L_UT); S.A = (const char*)(ws + WS_XB1); S.Bt = (const char*)(ws + WS_WGU); S.list = (const int*)(ws + WS_LIST); S.K = D; S.bstride_e = (size_t)2 * FF * D * 2; S.gather = true;
        pg8::EpiGU E{(bf16_t*)(ws + WS_HID), args.b_gu};
        pg8::gemm_phase<pg8::EpiGU, pg8::MoeGuOrder>(F.lds, D, S, E);
        GRID_BAR(5);
    }

    if (IN(6)) {
        moe_tables(F, args, 4);
        pg8::MoeDnOrder S; S.ut = (const LAS int*)(F.lds + L_UT); S.A = (const char*)(ws + WS_HID); S.Bt = (const char*)(ws + WS_WDN); S.list = (const int*)(ws + WS_LIST); S.K = FF; S.bstride_e = (size_t)D * FF * 2; S.gather = false;
        pg8::EpiDown E{(bf16_t*)(ws + WS_Y), args.b_dn, (const int*)(ws + WS_LIST)};
        pg8::gemm_phase<pg8::EpiDown, pg8::MoeDnOrder>(F.lds, FF, S, E);
        GRID_BAR(6);
    }

    if (IN(7)) { p7_combine_ln2(F, args); GRID_BAR(7); }

    if (IN(8)) {
        pg8::DenseOrder S; S.init(ws + WS_XB1, ws + WS_WG, M, D, D, F.G, (int)blockIdx.x); pg8::EpiGate E{args.out, (const bf16_t*)(ws + WS_PLE), args.ple_gate_b};
        pg8::gemm_phase<pg8::EpiGate, pg8::DenseOrder>(F.lds, D, S, E);
        GRID_BAR(8);
    }

    if (IN(9)) { p9_ln3(F, args); }
#undef IN
#undef GRID_BAR
}

extern "C" void kernel_launch(void* const* d_in, const int* in_sizes, int n_in, void* d_out, int out_size, void* d_ws, size_t ws_size, hipStream_t stream) {
    static int grid = 0;
    if (grid == 0) {
        if (n_in != 22 || in_sizes[0] != M * D || out_size != M * D || ws_size < WS_END) { fprintf(stderr, "kernel_launch: unexpected shapes (n_in %d, in0 %d, out %d, ws %zu); nothing launched\n", n_in, n_in > 0 ? in_sizes[0] : -1, out_size, ws_size); grid = -1; return; }
        int dev = 0, cus = 0, per_cu = 0;
        if (hipGetDevice(&dev) != hipSuccess || hipDeviceGetAttribute(&cus, hipDeviceAttributeMultiprocessorCount, dev) != hipSuccess) { grid = -1; return; }
        if (hipFuncSetAttribute((const void*)fwd_kernel, hipFuncAttributeMaxDynamicSharedMemorySize, LDS_BYTES) != hipSuccess) { fprintf(stderr, "kernel_launch: hipFuncSetAttribute failed\n"); grid = -1; return; }
        if (hipOccupancyMaxActiveBlocksPerMultiprocessor(&per_cu, (const void*)fwd_kernel, 512, LDS_BYTES) != hipSuccess || per_cu < 1) fprintf(stderr, "kernel_launch: occupancy query reports %d\n", per_cu);
        (void)hipGetLastError();
        grid = cus;
        if (grid != 256) fprintf(stderr, "kernel_launch: %d CUs (expected 256)\n", grid);
    }
    if (grid < 0) return;
    (void)hipMemsetAsync((char*)d_ws + WS_CTL, 0, CTL_ZERO_BYTES, stream);
    Args a{};
    const float** ap = (const float**)&a;
    for (int i = 0; i < 22; ++i) ap[i] = (const float*)d_in[i];
    a.out = (float*)d_out; a.ws = (unsigned char*)d_ws;
#if MK_N_LAUNCHES == 1
    a.ph_lo = 0; a.ph_hi = NPHASE;
    hipLaunchKernelGGL(fwd_kernel, dim3(grid), dim3(512), LDS_BYTES, stream, a);
#else
    for (int ph = 0; ph < NPHASE; ++ph) { a.ph_lo = ph; a.ph_hi = ph + 1; hipLaunchKernelGGL(fwd_kernel, dim3(grid), dim3(512), LDS_BYTES, stream, a); }
#endif
}
```

```cpp
#include <hip/hip_runtime.h>
#include <cstdio>
#include <cstdint>

#ifndef MK_N_LAUNCHES
#define MK_N_LAUNCHES 1
#endif

#ifndef REP0
#define REP0 1
#endif
#ifndef REP1
#define REP1 1
#endif
#ifndef REP2
#define REP2 1
#endif
#ifndef REP3
#define REP3 1
#endif
#ifndef REP5
#define REP5 1
#endif
#ifndef REP6
#define REP6 1
#endif
#define LAS __attribute__((address_space(3)))
#define GAS __attribute__((address_space(1)))
typedef unsigned short bf16_t;
typedef short bf16x8 __attribute__((ext_vector_type(8)));
typedef float f32x4 __attribute__((ext_vector_type(4)));
typedef float f32x2 __attribute__((ext_vector_type(2)));
typedef unsigned u32x4 __attribute__((ext_vector_type(4)));
typedef unsigned u32x2 __attribute__((ext_vector_type(2)));
typedef GAS unsigned gu32;

constexpr int M = 32768, D = 1024, SEQ = 4096, DIN = 2048, NE = 32, TOPK = 4, FF = 1024, PLE = 256, DPOOL = 512;
constexpr int NA = M * TOPK;
constexpr int LCAP = M;
constexpr int MAXTILES = NA / 256 + NE;
constexpr float ALPHA = 1.189207115002721f;
constexpr float LN_EPS = 1e-5f;
constexpr float SW_LIMIT = 7.0f, SW_ALPHA = 1.702f;
constexpr int NPHASE = 10;

constexpr size_t MiB = 1u << 20;
constexpr size_t WS_CTL = 0, CTL_ZERO_BYTES = 1 * MiB;
constexpr size_t WS_WIN = 1 * MiB;
constexpr size_t WS_W2 = 5 * MiB;
constexpr size_t WS_WG = 7 * MiB;
constexpr size_t WS_WP = 9 * MiB;
constexpr size_t WS_TG = 10 * MiB;
constexpr size_t WS_LIST = 11 * MiB;
constexpr size_t WS_WGU = 16 * MiB;
constexpr size_t WS_WDN = 144 * MiB;
constexpr size_t WS_XB1 = 208 * MiB;
constexpr size_t WS_PLE = 272 * MiB;
constexpr size_t WS_HID = 336 * MiB;
constexpr size_t WS_PROJ = 336 * MiB;
constexpr size_t WS_A2 = 464 * MiB;
constexpr size_t WS_XB = 528 * MiB;
constexpr size_t WS_PB = 592 * MiB;
constexpr size_t WS_Y = 608 * MiB;
constexpr size_t WS_END = 864 * MiB;
static_assert(WS_HID + (size_t)MAXTILES * 256 * 1024 * 2 <= WS_Y, "hidden fits");
constexpr int CW_TMO = 0, CW_CODE = 1, CW_CNT = 64  , CW_BAR = 4096;

constexpr int RING_BYTES = 131072;
constexpr int L_MISC = RING_BYTES;
constexpr int L_TST = RING_BYTES + 128;
constexpr int L_CNT = RING_BYTES + 272;
constexpr int L_UT = RING_BYTES + 640;
constexpr int L_HIST = RING_BYTES + 1664;
constexpr int L_BASE = RING_BYTES + 1792;
constexpr int L_ASG = RING_BYTES + 2048;
constexpr int LDS_BYTES = 147456;
static_assert(L_ASG + 2048 <= LDS_BYTES, "LDS map");

#define RLX_AGENT __ATOMIC_RELAXED, __HIP_MEMORY_SCOPE_AGENT
#define LDS_WAIT() asm volatile("s_waitcnt lgkmcnt(0)" ::: "memory")
#define VM_WAIT() asm volatile("s_waitcnt vmcnt(0)" ::: "memory")

__device__ __forceinline__ unsigned cvt_pk_bf16(float lo, float hi) { unsigned r; asm volatile("v_cvt_pk_bf16_f32 %0, %1, %2" : "=v"(r) : "v"(lo), "v"(hi)); return r; }
__device__ __forceinline__ float bf_lo(unsigned w) { return __uint_as_float(w << 16); }
__device__ __forceinline__ float bf_hi(unsigned w) { return __uint_as_float(w & 0xffff0000u); }
__device__ __forceinline__ float wave_sum(float v) {
#pragma unroll
    for (int o = 1; o < 64; o <<= 1) v += __shfl_xor(v, o);
    return v;
}

namespace pg8 {
constexpr int BM = 256, BK = 64, HALF = 128, HTB = HALF * BK * 2, STAGE_BYTES = 8 * HTB, NXCD = 8, WGM = 8;
__host__ __device__ __forceinline__ int lds_byte(int r, int c) { const int st = (r >> 4) * 2 + (c >> 5), rr = r & 15, cc = c & 31, ob = rr * 64 + cc * 2; return st * 1024 + (ob ^ (((ob >> 9) & 1) << 5)); }
__host__ __device__ __forceinline__ void stage_rc(int b, int& R, int& C) { const int st = b / 1024, sb = b % 1024, swz = sb ^ (((sb >> 9) & 1) << 5); R = (st >> 1) * 16 + swz / 64; C = (st & 1) * 32 + (swz % 64) / 2; }
__host__ __device__ __forceinline__ int perm32(int rho) { const int n = rho >> 4, i = rho & 15; return 8 * (i >> 2) + 4 * n + (i & 3); }

struct Unit { const char* A; const char* B; int pm, pn, e, lbase, nvalid; };

struct DenseOrder {
    static constexpr bool GATHER = false;
    const char* A; const char* Bt; int K, nM, nN, nwg, G, c;
    __device__ __forceinline__ void init(const void* A_, const void* Bt_, int M_, int N_, int K_, int G_, int c_) { A = (const char*)A_; Bt = (const char*)Bt_; K = K_; nM = M_ / BM; nN = N_ / BM; nwg = nM * nN; G = G_; c = c_; }
    __device__ __forceinline__ bool next(int i, Unit& u) const {
        const long L = (long)i * G + c; if (L >= nwg) return false;
        int wgid = (int)L; { const int q = nwg / NXCD, r = nwg % NXCD, xcd = wgid % NXCD, off = wgid / NXCD; wgid = (xcd < r ? xcd * (q + 1) : r * (q + 1) + (xcd - r) * q) + off; }
        const int nig = WGM * nN, gid = wgid / nig, fm = gid * WGM, gsz = (nM - fm) < WGM ? (nM - fm) : WGM;
        u.pm = fm + ((wgid % nig) % gsz); u.pn = (wgid % nig) / gsz;
        u.A = A + (size_t)u.pm * BM * K * 2; u.B = Bt + (size_t)u.pn * BM * K * 2; u.e = 0; u.lbase = 0; u.nvalid = BM; return true;
    }
    __device__ __forceinline__ void rows(const Unit&, int R0, unsigned (&off)[4]) const {
#pragma unroll
        for (int j = 0; j < 4; ++j) off[j] = (unsigned)((R0 + 64 * j) * K * 2);
    }
};

struct MoeOrder {
    const LAS int* ut; const char* A; const char* Bt; const int* list; int K; size_t bstride_e; bool gather;
    __device__ __forceinline__ bool next_(int i, Unit& u) const {
        if (i >= 32) return false;
        const LAS int* t = ut + i * 8;
        const int e = __builtin_amdgcn_readfirstlane(t[0]), tile = __builtin_amdgcn_readfirstlane(t[1]), pn = __builtin_amdgcn_readfirstlane(t[2]), valid = __builtin_amdgcn_readfirstlane(t[3]);
        const int lb = __builtin_amdgcn_readfirstlane(t[4]), nv = __builtin_amdgcn_readfirstlane(t[5]);
        if (!valid) return false;
        u.e = e; u.pm = tile; u.pn = pn; u.lbase = lb; u.nvalid = nv;
        u.B = Bt + (size_t)e * bstride_e + (size_t)pn * BM * K * 2;
        u.A = gather ? A : A + (size_t)tile * BM * K * 2;
        return true;
    }
};
struct MoeGuOrder : MoeOrder {
    static constexpr bool GATHER = true;
    __device__ __forceinline__ bool next(int i, Unit& u) const { return next_(i, u); }
    __device__ __forceinline__ void rows(const Unit& u, int R0, unsigned (&off)[4]) const {
#pragma unroll
        for (int j = 0; j < 4; ++j) { const int r = R0 + 64 * j; int aid = 0; if (r < u.nvalid) aid = list[u.lbase + r]; off[j] = (unsigned)(aid >> 2) * (unsigned)(K * 2); }
    }
};
struct MoeDnOrder : MoeOrder {
    static constexpr bool GATHER = false;
    __device__ __forceinline__ bool next(int i, Unit& u) const { return next_(i, u); }
    __device__ __forceinline__ void rows(const Unit&, int R0, unsigned (&off)[4]) const {
#pragma unroll
        for (int j = 0; j < 4; ++j) off[j] = (unsigned)((R0 + 64 * j) * K * 2);
    }
};

struct EpiBf16 {
    static constexpr bool PERM = true;
    bf16_t* O; int ldc;
    __device__ __forceinline__ void operator()(const f32x4 (&acc)[2][2][4][2], const Unit& u, int wr, int wc, int fr, int fq) const {
        const int row0 = u.pm * BM + wr * 64 + fr, col0 = u.pn * BM + wc * 32 + 8 * fq;
#pragma unroll
        for (int ai = 0; ai < 2; ++ai)
#pragma unroll
            for (int m = 0; m < 4; ++m) { bf16_t* rowp = O + (size_t)(row0 + ai * HALF + m * 16) * ldc + col0;
#pragma unroll
                for (int bj = 0; bj < 2; ++bj) { const f32x4 v0 = acc[ai][bj][m][0], v1 = acc[ai][bj][m][1];
                    u32x4 w; w.x = cvt_pk_bf16(v0[0], v0[1]); w.y = cvt_pk_bf16(v0[2], v0[3]); w.z = cvt_pk_bf16(v1[0], v1[1]); w.w = cvt_pk_bf16(v1[2], v1[3]);
                    *(u32x4*)(rowp + bj * HALF) = w; } }
    }
};
struct EpiH1 {
    static constexpr bool PERM = false;
    const float* x; float* out;
    __device__ __forceinline__ void operator()(const f32x4 (&acc)[2][2][4][2], const Unit& u, int wr, int wc, int fr, int fq) const {
        const int row0 = u.pm * BM + wr * 64 + fr, col0 = u.pn * BM + wc * 32 + 4 * fq;
#pragma unroll
        for (int ai = 0; ai < 2; ++ai)
#pragma unroll
            for (int m = 0; m < 4; ++m) { const size_t off = (size_t)(row0 + ai * HALF + m * 16) * D + col0;
#pragma unroll
                for (int bj = 0; bj < 2; ++bj)
#pragma unroll
                    for (int n = 0; n < 2; ++n) { const f32x4 xv = *(const f32x4*)(x + off + bj * HALF + n * 16); *(f32x4*)(out + off + bj * HALF + n * 16) = xv * ALPHA + acc[ai][bj][m][n]; }
                asm volatile("" ::: "memory"); }
    }
};
struct EpiGU {
    static constexpr bool PERM = true;
    bf16_t* H; const float* bgu;
    __device__ __forceinline__ void operator()(const f32x4 (&acc)[2][2][4][2], const Unit& u, int wr, int wc, int fr, int fq) const {
        const int row0 = u.pm * BM + wr * 64 + fr, cc = u.pn * HALF + wc * 32 + 8 * fq;
        const float* bp = bgu + (size_t)u.e * (2 * FF) + cc;
        f32x4 bg[2], bu[2];
#pragma unroll
        for (int n = 0; n < 2; ++n) { bg[n] = *(const f32x4*)(bp + 4 * n); bu[n] = *(const f32x4*)(bp + FF + 4 * n); }
#pragma unroll
        for (int ai = 0; ai < 2; ++ai)
#pragma unroll
            for (int m = 0; m < 4; ++m) { bf16_t* rowp = H + (size_t)(row0 + ai * HALF + m * 16) * FF + cc; float h[8];
#pragma unroll
                for (int n = 0; n < 2; ++n)
#pragma unroll
                    for (int i = 0; i < 4; ++i) {
                        const float g = fminf(acc[ai][0][m][n][i] + bg[n][i], SW_LIMIT);
                        const float up = fminf(fmaxf(acc[ai][1][m][n][i] + bu[n][i], -SW_LIMIT), SW_LIMIT);
                        const float sg = __builtin_amdgcn_rcpf(1.0f + __builtin_amdgcn_exp2f(g * (-SW_ALPHA * 1.4426950408889634f)));
                        h[4 * n + i] = (up + 1.0f) * (g * sg); }
                u32x4 w; w.x = cvt_pk_bf16(h[0], h[1]); w.y = cvt_pk_bf16(h[2], h[3]); w.z = cvt_pk_bf16(h[4], h[5]); w.w = cvt_pk_bf16(h[6], h[7]);
                *(u32x4*)rowp = w; }
    }
};
struct EpiDown {
    static constexpr bool PERM = true;
    bf16_t* Y; const float* bdn; const int* list;
    __device__ __forceinline__ void operator()(const f32x4 (&acc)[2][2][4][2], const Unit& u, int wr, int wc, int fr, int fq) const {
        const int col0 = u.pn * BM + wc * 32 + 8 * fq;
        const float* bp = bdn + (size_t)u.e * D + col0;
        f32x4 bv[2][2];
#pragma unroll
        for (int bj = 0; bj < 2; ++bj)
#pragma unroll
            for (int n = 0; n < 2; ++n) bv[bj][n] = *(const f32x4*)(bp + bj * HALF + 4 * n);
#pragma unroll
        for (int ai = 0; ai < 2; ++ai)
#pragma unroll
            for (int m = 0; m < 4; ++m) { const int r = ai * HALF + wr * 64 + m * 16 + fr;
                if (r < u.nvalid) { const int aid = list[u.lbase + r]; bf16_t* rowp = Y + (size_t)aid * D + col0;
#pragma unroll
                    for (int bj = 0; bj < 2; ++bj) { const f32x4 v0 = acc[ai][bj][m][0] + bv[bj][0], v1 = acc[ai][bj][m][1] + bv[bj][1];
                        u32x4 w; w.x = cvt_pk_bf16(v0[0], v0[1]); w.y = cvt_pk_bf16(v0[2], v0[3]); w.z = cvt_pk_bf16(v1[0], v1[1]); w.w = cvt_pk_bf16(v1[2], v1[3]);
                        *(u32x4*)(rowp + bj * HALF) = w; } } }
    }
};
struct EpiGate {
    static constexpr bool PERM = false;
    float* xo; const bf16_t* ple; const float* bg;
    __device__ __forceinline__ void operator()(const f32x4 (&acc)[2][2][4][2], const Unit& u, int wr, int wc, int fr, int fq) const {
        const int row0 = u.pm * BM + wr * 64 + fr, col0 = u.pn * BM + wc * 32 + 4 * fq;
        f32x4 bv[2][2];
#pragma unroll
        for (int bj = 0; bj < 2; ++bj)
#pragma unroll
            for (int n = 0; n < 2; ++n) bv[bj][n] = *(const f32x4*)(bg + col0 + bj * HALF + n * 16);
#pragma unroll
        for (int ai = 0; ai < 2; ++ai)
#pragma unroll
            for (int m = 0; m < 4; ++m) { const size_t off = (size_t)(row0 + ai * HALF + m * 16) * D + col0;
#pragma unroll
                for (int bj = 0; bj < 2; ++bj)
#pragma unroll
                    for (int n = 0; n < 2; ++n) { const size_t o = off + bj * HALF + n * 16; const f32x4 xv = *(const f32x4*)(xo + o); const u32x2 pw = *(const u32x2*)(ple + o);
                        const f32x4 z = acc[ai][bj][m][n] + bv[bj][n]; f32x4 r;
                        const float pl[4] = {bf_lo(pw.x), bf_hi(pw.x), bf_lo(pw.y), bf_hi(pw.y)};
#pragma unroll
                        for (int i = 0; i < 4; ++i) { const float sg = __builtin_amdgcn_rcpf(1.0f + __builtin_amdgcn_exp2f(z[i] * -1.4426950408889634f)); r[i] = xv[i] * ALPHA + sg * pl[i]; }
                        *(f32x4*)(xo + o) = r; }
                asm volatile("" ::: "memory"); }
    }
};

template <class Epi, class Sched>
__device__ __forceinline__ void gemm_phase(LAS unsigned char* lds, const int K, const Sched& S, const Epi& E) {
    const int tid = threadIdx.x, wid = __builtin_amdgcn_readfirstlane(tid >> 6), lane = tid & 63, wr = wid >> 2, wc = wid & 3, fr = lane & 15, fq = lane >> 4;
    const int nt = K / BK;
    int R0, C0; stage_rc(tid * 16, R0, C0);
    unsigned voffB[2];
#pragma unroll
    for (int i = 0; i < 2; ++i) { const int R = R0 + 64 * i; const int Rb = Epi::PERM ? ((R & ~31) + perm32(R & 31)) : R; voffB[i] = (unsigned)(Rb * K + C0) * 2u; }
    const unsigned coff = (unsigned)C0 * 2u;
    const size_t kstep = (size_t)(BK * 2);
    const size_t hstep = (size_t)HALF * K * 2;
    const unsigned ldsw = (unsigned)wid * 1024u;
    const int aoff = lds_byte(wr * 64 + fr, fq * 8), boff = lds_byte(wc * 32 + fr, fq * 8);
#define PG8_SA(b, h) (((b) * 2 + (h)) * HTB)
#define PG8_SB(b, h) ((4 + (b) * 2 + (h)) * HTB)
#define PG8_STAGE_B(bufoff, gbase) do { _Pragma("unroll") for (int _i = 0; _i < 2; ++_i) \
        __builtin_amdgcn_global_load_lds((const unsigned*)((const char*)(gbase) + voffB[_i]), (LAS unsigned*)(lds + (bufoff) + ldsw + _i * 8192), 16, 0, 0); } while (0)
#define PG8_STAGE_A(bufoff, gbase, off, h) do { _Pragma("unroll") for (int _i = 0; _i < 2; ++_i) \
        __builtin_amdgcn_global_load_lds((const unsigned*)((const char*)(gbase) + (off)[2 * (h) + _i]), (LAS unsigned*)(lds + (bufoff) + ldsw + _i * 8192), 16, 0, 0); } while (0)
#define PG8_LDA(dst, b, h) do { _Pragma("unroll") for (int m = 0; m < 4; ++m) _Pragma("unroll") for (int k = 0; k < 2; ++k) dst[m][k] = *(const LAS bf16x8*)(lds + PG8_SA(b, h) + aoff + m * 2048 + k * 1024); } while (0)
#define PG8_LDB(dst, b, h) do { _Pragma("unroll") for (int n = 0; n < 2; ++n) _Pragma("unroll") for (int k = 0; k < 2; ++k) dst[n][k] = *(const LAS bf16x8*)(lds + PG8_SB(b, h) + boff + n * 2048 + k * 1024); } while (0)
#define PG8_MMA(ai, bj, At, Bt) do { __builtin_amdgcn_s_setprio(1); _Pragma("unroll") for (int m = 0; m < 4; ++m) _Pragma("unroll") for (int n = 0; n < 2; ++n) _Pragma("unroll") for (int k = 0; k < 2; ++k) \
        acc[ai][bj][m][n] = __builtin_amdgcn_mfma_f32_16x16x32_bf16(Bt[n][k], At[m][k], acc[ai][bj][m][n], 0, 0, 0); __builtin_amdgcn_s_setprio(0); } while (0)
#define PG8_WAIT_V(n) asm volatile("s_waitcnt vmcnt(" #n ")" ::: "memory")
#define PG8_WAIT_L(n) asm volatile("s_waitcnt lgkmcnt(" #n ")" ::: "memory")
#define PG8_BAR __builtin_amdgcn_s_barrier()
#define PG8_SCHED __builtin_amdgcn_sched_barrier(0)
#define PG8_PIN4(o) asm volatile("" : "+v"((o)[0]), "+v"((o)[1]), "+v"((o)[2]), "+v"((o)[3]))
    Unit cur, nxt, nn; int ui = 0;
    if (!S.next(0, cur)) return;
    bool has_next = S.next(1, nxt);
    unsigned offc[4], offn[4], offnn[4];
    S.rows(cur, R0, offc);
    if (has_next) S.rows(nxt, R0, offn); else { _Pragma("unroll") for (int j = 0; j < 4; ++j) offn[j] = offc[j]; }
#pragma unroll
    for (int j = 0; j < 4; ++j) { offc[j] += coff; if (has_next) offn[j] += coff; else offn[j] = offc[j]; }
    if constexpr (Sched::GATHER) { PG8_PIN4(offc); PG8_PIN4(offn); }
    f32x4 acc[2][2][4][2];
#pragma unroll
    for (int a = 0; a < 2; ++a)
#pragma unroll
        for (int b = 0; b < 2; ++b)
#pragma unroll
            for (int m = 0; m < 4; ++m)
#pragma unroll
                for (int n = 0; n < 2; ++n) acc[a][b][m][n] = (f32x4){0.f, 0.f, 0.f, 0.f};
    bf16x8 At[4][2], B0[2][2], B1[2][2];
    const char* cA = cur.A; const char* cB = cur.B;
    PG8_STAGE_B(PG8_SB(0, 0), cB); PG8_STAGE_B(PG8_SB(0, 1), cB + hstep); PG8_STAGE_A(PG8_SA(0, 0), cA, offc, 0); PG8_STAGE_A(PG8_SA(0, 1), cA, offc, 1);
    if (wr == 1) PG8_BAR;
    PG8_WAIT_V(2); PG8_BAR;
    PG8_STAGE_B(PG8_SB(1, 0), cB + kstep); PG8_STAGE_A(PG8_SA(1, 0), cA + kstep, offc, 0); PG8_STAGE_B(PG8_SB(1, 1), cB + hstep + kstep);
    PG8_WAIT_V(6); PG8_BAR;
    for (;;) {
        const char* nA = has_next ? nxt.A : cA; const char* nB = has_next ? nxt.B : cB;
        for (int t = 0; t < nt; t += 2) {
            const bool last = (t == nt - 2);
            const char* a1 = cA + (size_t)(t + 1) * kstep;
            const char* a2 = last ? nA : cA + (size_t)(t + 2) * kstep; const char* b2 = last ? nB : cB + (size_t)(t + 2) * kstep;
            const char* a3 = a2 + kstep; const char* b3 = b2 + kstep;
            unsigned o2[4];
#pragma unroll
            for (int j = 0; j < 4; ++j) o2[j] = Sched::GATHER ? (last ? offn[j] : offc[j]) : offc[j];
            PG8_LDB(B0, 0, 0); PG8_LDB(B1, 0, 1); PG8_SCHED; PG8_LDA(At, 0, 0); PG8_STAGE_A(PG8_SA(1, 1), a1, offc, 1);
            PG8_WAIT_V(8); PG8_WAIT_L(0); PG8_BAR; PG8_MMA(0, 0, At, B0); PG8_MMA(0, 1, At, B1); PG8_BAR; PG8_SCHED;
            PG8_LDA(At, 0, 1); PG8_STAGE_B(PG8_SB(0, 0), b2); PG8_STAGE_B(PG8_SB(0, 1), b2 + hstep); PG8_STAGE_A(PG8_SA(0, 0), a2, o2, 0);
            PG8_WAIT_V(8); PG8_WAIT_L(0); PG8_BAR; PG8_MMA(1, 0, At, B0); PG8_MMA(1, 1, At, B1); PG8_BAR; PG8_SCHED;
            PG8_LDB(B0, 1, 0); PG8_LDB(B1, 1, 1); PG8_SCHED; PG8_LDA(At, 1, 0); PG8_STAGE_A(PG8_SA(0, 1), a2, o2, 1);
            PG8_WAIT_V(8); PG8_WAIT_L(0); PG8_BAR; PG8_MMA(0, 0, At, B0); PG8_MMA(0, 1, At, B1); PG8_BAR; PG8_SCHED;
            PG8_LDA(At, 1, 1); PG8_STAGE_B(PG8_SB(1, 0), b3); PG8_STAGE_B(PG8_SB(1, 1), b3 + hstep); PG8_STAGE_A(PG8_SA(1, 0), a3, o2, 0);
            PG8_WAIT_V(8); PG8_WAIT_L(0); PG8_BAR; PG8_MMA(1, 0, At, B0); PG8_MMA(1, 1, At, B1); PG8_BAR; PG8_SCHED;
        }
        if (wr == 0) PG8_BAR;
        bool has2 = false;
        if (has_next) { has2 = S.next(ui + 2, nn); if (has2) { S.rows(nn, R0, offnn); } }
        { int fr_e = fr, fq_e = fq; asm volatile("" : "+v"(fr_e), "+v"(fq_e));
          E(acc, cur, wr, wc, fr_e, fq_e); }
        if (!has_next) break;
#pragma unroll
        for (int a = 0; a < 2; ++a)
#pragma unroll
            for (int b = 0; b < 2; ++b)
#pragma unroll
                for (int m = 0; m < 4; ++m)
#pragma unroll
                    for (int n = 0; n < 2; ++n) acc[a][b][m][n] = (f32x4){0.f, 0.f, 0.f, 0.f};
        cur = nxt; cA = nA; cB = nB; ++ui;
#pragma unroll
        for (int j = 0; j < 4; ++j) { offc[j] = offn[j]; if (has2) offn[j] = offnn[j] + coff; }
        if (has2) nxt = nn;
        has_next = has2;
        if constexpr (Sched::GATHER) { PG8_PIN4(offn); }
        if (wr == 1) PG8_BAR;
    }
    PG8_WAIT_V(0);
    PG8_BAR;
#undef PG8_SA
#undef PG8_SB
#undef PG8_STAGE_A
#undef PG8_STAGE_B
#undef PG8_LDA
#undef PG8_LDB
#undef PG8_MMA
#undef PG8_WAIT_V
#undef PG8_WAIT_L
#undef PG8_BAR
#undef PG8_SCHED
#undef PG8_PIN4
}
}

#define XB_TMO      128
#define XB_XCNT(j)  (256  + 64 * (j))
#define XB_XSUB(j)  (1280 + 64 * (j))
#define XB_XGEN(j)  (2304 + 64 * (j))
#define XB_TOP      3328
#define XB_TOPGEN   3392
#define XCD_BAR_WORDS 3456
#define XB_SPIN_CAP (1u << 18)
__device__ __forceinline__ unsigned xb_ld(unsigned* p)              { return __hip_atomic_load(p, __ATOMIC_RELAXED, __HIP_MEMORY_SCOPE_AGENT); }
__device__ __forceinline__ unsigned xb_add(unsigned* p, unsigned v) { return __hip_atomic_fetch_add(p, v, __ATOMIC_RELAXED, __HIP_MEMORY_SCOPE_AGENT); }
__device__ __forceinline__ unsigned xb_xcc_id() { return (unsigned)__builtin_amdgcn_s_getreg((3 << 11) | 20) & 0xFu; }
#define XB_SPIN(cond, bar) do { unsigned _sp = 0; while (cond) { __builtin_amdgcn_s_sleep(1); \
    if ((++_sp & 255u) == 0u) { if (xb_ld(&(bar)[XB_TMO])) break; if (_sp > XB_SPIN_CAP) { atomicAdd(&(bar)[XB_TMO], 1u); break; } } } } while (0)
struct XcdBarrier { unsigned* bar; unsigned x; volatile LAS unsigned* st; };
__device__ __forceinline__ XcdBarrier xcd_barrier_post(unsigned* bar, volatile LAS unsigned* st) {
    XcdBarrier b; b.bar = bar; b.x = xb_xcc_id(); b.st = st;
    if (threadIdx.x == 0) (void)xb_add(&bar[XB_XCNT(b.x)], 1u);
    return b;
}
__device__ __forceinline__ void xcd_barrier_complete(unsigned* bar, unsigned x, unsigned& nloc, unsigned& nx) {
    const unsigned G = gridDim.x * gridDim.y * gridDim.z;
    unsigned sum, cnt, mine, sp = 0u;
    for (;;) {
        sum = 0u; cnt = 0u; mine = 0u;
#pragma unroll
        for (unsigned j = 0; j < 16; ++j) { const unsigned c = xb_ld(&bar[XB_XCNT(j)]); sum += c; cnt += (c > 0u) ? 1u : 0u; mine = (j == x) ? c : mine; }
        if (sum == G) break;
        __builtin_amdgcn_s_sleep(1);
        if ((++sp & 255u) == 0u) { if (xb_ld(&bar[XB_TMO])) break; if (sp > XB_SPIN_CAP) { atomicAdd(&bar[XB_TMO], 1u); break; } }
    }
    nloc = mine > 0u ? mine : 1u; nx = cnt > 0u ? cnt : 1u;
}
__device__ __forceinline__ void xcd_barrier(const XcdBarrier& b) {
    asm volatile("s_waitcnt vmcnt(0)" ::: "memory");
    __syncthreads();
    if (threadIdx.x == 0) {
        unsigned* bar = b.bar;
        __builtin_amdgcn_s_waitcnt(0);
        unsigned nloc = b.st[0], nx = b.st[1];
        if (nloc == 0u) { xcd_barrier_complete(bar, b.x, nloc, nx); b.st[0] = nloc; b.st[1] = nx; }
        const unsigned old = xb_add(&bar[XB_XSUB(b.x)], 1u);
        const unsigned gen = old / nloc;
        if (old + 1u == (gen + 1u) * nloc) {
            __builtin_amdgcn_fence(__ATOMIC_RELEASE, "agent");
            asm volatile("s_waitcnt vmcnt(0)" ::: "memory");
            const unsigned og = xb_add(&bar[XB_TOP], 1u);
            const unsigned tg = og / nx;
            if (og + 1u == (tg + 1u) * nx) xb_add(&bar[XB_TOPGEN], 1u);
            else XB_SPIN(xb_ld(&bar[XB_TOPGEN]) == tg, bar);
            __builtin_amdgcn_fence(__ATOMIC_ACQUIRE, "agent");
            xb_add(&bar[XB_XGEN(b.x)], 1u);
            asm volatile("s_waitcnt vmcnt(0)" ::: "memory");
        } else {
            XB_SPIN(xb_ld(&bar[XB_XGEN(b.x)]) == gen, bar);
            __builtin_amdgcn_fence(__ATOMIC_ACQUIRE, "agent");
            asm volatile("s_waitcnt vmcnt(0)" ::: "memory");
        }
    }
    __syncthreads();
}

struct Args {
    const float* x; const float* p; const float* w_in; const float* pool_mix; const float* pool_scale; const float* conv_w; const float* w_out;
    const float* ln1_g; const float* ln1_b; const float* router_w; const float* router_b; const float* w_gu; const float* b_gu; const float* w_dn; const float* b_dn;
    const float* ln2_g; const float* ln2_b; const float* ple_proj; const float* ple_gate_w; const float* ple_gate_b; const float* ln3_g; const float* ln3_b;
    float* out; unsigned char* ws; int ph_lo, ph_hi;
};
struct Frame { LAS unsigned char* lds; int tid, lane, wave, vcu, G; };

__device__ __forceinline__ void tr_item(const float* src, int ld_src, bf16_t* dst, int ld_dst, LAS float* scr, int lane) {
    const int kr = lane >> 3, nq = lane & 7;
    f32x4 v[8];
#pragma unroll
    for (int r = 0; r < 8; ++r) v[r] = *(const f32x4*)(src + (size_t)(8 * r + kr) * ld_src + 4 * nq);
#pragma unroll
    for (int r = 0; r < 8; ++r)
#pragma unroll
        for (int q = 0; q < 4; ++q) scr[(8 * r + kr) * 33 + 4 * nq + q] = v[r][q];
    LDS_WAIT(); asm volatile("" ::: "memory");
    const int c = lane & 7;
#pragma unroll
    for (int j = 0; j < 4; ++j) { const int n = (lane >> 3) + 8 * j; const LAS float* s = scr + (8 * c) * 33 + n;
        u32x4 o; o.x = cvt_pk_bf16(s[0 * 33], s[1 * 33]); o.y = cvt_pk_bf16(s[2 * 33], s[3 * 33]); o.z = cvt_pk_bf16(s[4 * 33], s[5 * 33]); o.w = cvt_pk_bf16(s[6 * 33], s[7 * 33]);
        *(u32x4*)(dst + (size_t)n * ld_dst + 8 * c) = o; }
    LDS_WAIT(); asm volatile("" ::: "memory");
}
__device__ __forceinline__ void fold_item(const Args& a, bf16_t* W2T, LAS float* scr, int item, int lane) {
    const int g = item >> 8, cb = (item >> 4) & 15, nb = item & 15, c0 = cb * 8, n = nb * 64 + lane;
#pragma unroll
    for (int i = 0; i < 16; ++i) { const int idx = i * 64 + lane, c = idx >> 7, d = idx & 127; scr[d * 8 + c] = a.pool_mix[(size_t)(g * 128 + c0 + c) * 128 + d]; }
    LDS_WAIT(); asm volatile("" ::: "memory");
    float acc[8];
#pragma unroll
    for (int c = 0; c < 8; ++c) acc[c] = 0.f;
#pragma unroll 4
    for (int d = 0; d < 128; ++d) {
        const float wv = a.w_out[(size_t)(g * 128 + d) * D + n] * a.pool_scale[g * 128 + d];
        const f32x4 p0 = *(const LAS f32x4*)(scr + d * 8), p1 = *(const LAS f32x4*)(scr + d * 8 + 4);
        acc[0] += p0[0] * wv; acc[1] += p0[1] * wv; acc[2] += p0[2] * wv; acc[3] += p0[3] * wv;
        acc[4] += p1[0] * wv; acc[5] += p1[1] * wv; acc[6] += p1[2] * wv; acc[7] += p1[3] * wv;
    }
    u32x4 o; o.x = cvt_pk_bf16(acc[0], acc[1]); o.y = cvt_pk_bf16(acc[2], acc[3]); o.z = cvt_pk_bf16(acc[4], acc[5]); o.w = cvt_pk_bf16(acc[6], acc[7]);
    *(u32x4*)(W2T + (size_t)n * D + g * 128 + c0) = o;
    LDS_WAIT(); asm volatile("" ::: "memory");
}
__device__ __forceinline__ void p0_prologue(const Frame& F, const Args& a) {
    unsigned char* ws = a.ws;
    LAS float* scr = (LAS float*)(F.lds + F.wave * 16384);
    const int gw = F.vcu * 8 + F.wave, NGW = F.G * 8;
    bf16_t* WinT = (bf16_t*)(ws + WS_WIN); bf16_t* W2T = (bf16_t*)(ws + WS_W2); bf16_t* WgT = (bf16_t*)(ws + WS_WG); bf16_t* WpT = (bf16_t*)(ws + WS_WP);
    bf16_t* WguT = (bf16_t*)(ws + WS_WGU); bf16_t* WdnT = (bf16_t*)(ws + WS_WDN);
    constexpr int I_FOLD = 1024, I_IN = 16 * 64, I_OUT = 8 * 32, I_G = 16 * 32, I_P = 4 * 32, I_GU = NE * 16 * 64, I_DN = NE * 16 * 32;
    constexpr int NITEMS = I_FOLD + I_IN + I_OUT + I_G + I_P + I_GU + I_DN;
    for (int it = gw; it < NITEMS; it += NGW) {
        int r = it;
        if (r < I_FOLD) { fold_item(a, W2T, scr, r, F.lane); continue; } r -= I_FOLD;
        if (r < I_IN) { const int kb = r >> 6, nb = r & 63; tr_item(a.w_in + (size_t)(64 * kb) * DIN + 32 * nb, DIN, WinT + (size_t)(32 * nb) * D + 64 * kb, D, scr, F.lane); continue; } r -= I_IN;
        if (r < I_OUT) { const int kb = r >> 5, nb = r & 31; tr_item(a.w_out + (size_t)(DPOOL + 64 * kb) * D + 32 * nb, D, W2T + (size_t)(32 * nb) * D + DPOOL + 64 * kb, D, scr, F.lane); continue; } r -= I_OUT;
        if (r < I_G) { const int kb = r >> 5, nb = r & 31; tr_item(a.ple_gate_w + (size_t)(64 * kb) * D + 32 * nb, D, WgT + (size_t)(32 * nb) * D + 64 * kb, D, scr, F.lane); continue; } r -= I_G;
        if (r < I_P) { const int kb = r >> 5, nb = r & 31; tr_item(a.ple_proj + (size_t)(64 * kb) * D + 32 * nb, D, WpT + (size_t)(32 * nb) * PLE + 64 * kb, PLE, scr, F.lane); continue; } r -= I_P;
        if (r < I_GU) { const int e = r >> 10, q = r & 1023, kb = q >> 6, nb = q & 63, n0 = 32 * nb;
            const int h = n0 >> 10, j = n0 & 1023, drow = (j >> 7) * 256 + h * 128 + (j & 127);
            tr_item(a.w_gu + ((size_t)e * D + 64 * kb) * (2 * FF) + n0, 2 * FF, WguT + ((size_t)e * (2 * FF) + drow) * D + 64 * kb, D, scr, F.lane); continue; } r -= I_GU;
        { const int e = r >> 9, q = r & 511, kb = q >> 5, nb = q & 31;
            tr_item(a.w_dn + ((size_t)e * FF + 64 * kb) * D + 32 * nb, D, WdnT + ((size_t)e * D + 32 * nb) * FF + 64 * kb, FF, scr, F.lane); }
    }
    const size_t gt = (size_t)F.vcu * 512 + F.tid, NT = (size_t)F.G * 512;
    { const f32x4* s = (const f32x4*)a.x; u32x4* d = (u32x4*)(ws + WS_XB);
        for (size_t i = gt; i < (size_t)M * D / 8; i += NT) { const f32x4 v0 = s[2 * i], v1 = s[2 * i + 1]; u32x4 o; o.x = cvt_pk_bf16(v0[0], v0[1]); o.y = cvt_pk_bf16(v0[2], v0[3]); o.z = cvt_pk_bf16(v1[0], v1[1]); o.w = cvt_pk_bf16(v1[2], v1[3]); d[i] = o; } }
    { const f32x4* s = (const f32x4*)a.p; u32x4* d = (u32x4*)(ws + WS_PB);
        for (size_t i = gt; i < (size_t)M * PLE / 8; i += NT) { const f32x4 v0 = s[2 * i], v1 = s[2 * i + 1]; u32x4 o; o.x = cvt_pk_bf16(v0[0], v0[1]); o.y = cvt_pk_bf16(v0[2], v0[3]); o.z = cvt_pk_bf16(v1[0], v1[1]); o.w = cvt_pk_bf16(v1[2], v1[3]); d[i] = o; } }
}

__device__ __forceinline__ void unpack8(const u32x4 w, float (&f)[8]) { f[0] = bf_lo(w.x); f[1] = bf_hi(w.x); f[2] = bf_lo(w.y); f[3] = bf_hi(w.y); f[4] = bf_lo(w.z); f[5] = bf_hi(w.z); f[6] = bf_lo(w.w); f[7] = bf_hi(w.w); }
template <int W>
__device__ __forceinline__ void pool_item(const bf16_t* proj, bf16_t* A2, int t0, int g, int lane) {
    const int cb = lane & 15, ts = lane >> 4, tb = t0 + 16 * ts, c = g * 128 + cb * 8, seq0 = tb & ~(SEQ - 1);
    u32x4 rows[15 + W];
#pragma unroll
    for (int i = 0; i < 15 + W; ++i) { const int tr = tb - (W - 1) + i; const int trc = tr < seq0 ? seq0 : tr; rows[i] = *(const u32x4*)(proj + (size_t)trc * DIN + c); }
#pragma unroll
    for (int i = 0; i < W - 1; ++i) { const int tr = tb - (W - 1) + i; if (tr < seq0) rows[i] = (u32x4){0u, 0u, 0u, 0u}; }
    float S[8];
#pragma unroll
    for (int q = 0; q < 8; ++q) S[q] = 0.f;
#pragma unroll
    for (int i = 0; i < W - 1; ++i) { float f[8]; unpack8(rows[i], f);
#pragma unroll
        for (int q = 0; q < 8; ++q) S[q] += f[q]; }
#pragma unroll
    for (int j = 0; j < 16; ++j) { float cur[8], old[8]; unpack8(rows[j + W - 1], cur); unpack8(rows[j], old);
        const int sp1 = tb + j - seq0 + 1; const float inv = sp1 >= W ? (1.0f / (float)W) : (1.0f / (float)sp1); float o[8];
#pragma unroll
        for (int q = 0; q < 8; ++q) { S[q] += cur[q]; o[q] = S[q] * inv - cur[q]; S[q] -= old[q]; }
        u32x4 w; w.x = cvt_pk_bf16(o[0], o[1]); w.y = cvt_pk_bf16(o[2], o[3]); w.z = cvt_pk_bf16(o[4], o[5]); w.w = cvt_pk_bf16(o[6], o[7]);
        *(u32x4*)(A2 + (size_t)(tb + j) * D + c) = w; }
}
__device__ __forceinline__ void conv_item(const bf16_t* proj, bf16_t* A2, const float (&cw)[3][8], int tb, int lane) {
    const int c = 8 * lane, seq0 = tb & ~(SEQ - 1);
    u32x4 rc[10], rv[10], rb[8];
#pragma unroll
    for (int i = 0; i < 10; ++i) { const int tr = tb - 2 + i; const int trc = tr < seq0 ? seq0 : tr; const bf16_t* rp = proj + (size_t)trc * DIN + c; rc[i] = *(const u32x4*)(rp + 1024); rv[i] = *(const u32x4*)(rp + 1536); }
#pragma unroll
    for (int j = 0; j < 8; ++j) rb[j] = *(const u32x4*)(proj + (size_t)(tb + j) * DIN + 512 + c);
    float u[3][8];
#pragma unroll
    for (int i = 0; i < 2; ++i) { float fc[8], fv[8]; unpack8(rc[i], fc); unpack8(rv[i], fv); const bool ok = (tb - 2 + i) >= seq0;
#pragma unroll
        for (int q = 0; q < 8; ++q) u[i][q] = ok ? fc[q] * fv[q] : 0.f; }
#pragma unroll
    for (int j = 0; j < 8; ++j) { float fc[8], fv[8], fb[8], y[8]; unpack8(rc[j + 2], fc); unpack8(rv[j + 2], fv); unpack8(rb[j], fb);
#pragma unroll
        for (int q = 0; q < 8; ++q) { u[2][q] = fc[q] * fv[q]; y[q] = fb[q] * (cw[0][q] * u[0][q] + cw[1][q] * u[1][q] + cw[2][q] * u[2][q]); u[0][q] = u[1][q]; u[1][q] = u[2][q]; }
        u32x4 w; w.x = cvt_pk_bf16(y[0], y[1]); w.y = cvt_pk_bf16(y[2], y[3]); w.z = cvt_pk_bf16(y[4], y[5]); w.w = cvt_pk_bf16(y[6], y[7]);
        *(u32x4*)(A2 + (size_t)(tb + j) * D + DPOOL + c) = w; }
}
__device__ __forceinline__ void p2_mixer(const Frame& F, const Args& a) {
    const bf16_t* proj = (const bf16_t*)(a.ws + WS_PROJ); bf16_t* A2 = (bf16_t*)(a.ws + WS_A2);
    const int gw = F.vcu * 8 + F.wave, NGW = F.G * 8;
    for (int it = gw; it < 4 * (M / 64); it += NGW) { const int g = it & 3, t0 = (it >> 2) * 64;
        if (g == 0) pool_item<2>(proj, A2, t0, 0, F.lane); else if (g == 1) pool_item<4>(proj, A2, t0, 1, F.lane); else if (g == 2) pool_item<8>(proj, A2, t0, 2, F.lane); else pool_item<16>(proj, A2, t0, 3, F.lane); }
    float cw[3][8];
#pragma unroll
    for (int k = 0; k < 3; ++k)
#pragma unroll
        for (int i = 0; i < 8; ++i) cw[k][i] = a.conv_w[k * DPOOL + 8 * F.lane + i];
    for (int it = gw; it < M / 8; it += NGW) conv_item(proj, A2, cw, it * 8, F.lane);
}

__device__ __forceinline__ void load_row16(const float* rp, int lane, float (&v)[16]) {
#pragma unroll
    for (int j = 0; j < 2; ++j) { const f32x4 a0 = *(const f32x4*)(rp + 8 * lane + 512 * j), a1 = *(const f32x4*)(rp + 8 * lane + 512 * j + 4);
#pragma unroll
        for (int i = 0; i < 4; ++i) { v[8 * j + i] = a0[i]; v[8 * j + 4 + i] = a1[i]; } }
}
__device__ __forceinline__ void store_row16(float* rp, int lane, const float (&v)[16]) {
#pragma unroll
    for (int j = 0; j < 2; ++j) { *(f32x4*)(rp + 8 * lane + 512 * j) = (f32x4){v[8 * j], v[8 * j + 1], v[8 * j + 2], v[8 * j + 3]}; *(f32x4*)(rp + 8 * lane + 512 * j + 4) = (f32x4){v[8 * j + 4], v[8 * j + 5], v[8 * j + 6], v[8 * j + 7]}; }
}
__device__ __forceinline__ void ln_row16(float (&v)[16], const float (&g)[16], const float (&b)[16]) {
    float s = 0.f;
#pragma unroll
    for (int i = 0; i < 16; ++i) s += v[i];
    const float mean = wave_sum(s) * (1.0f / D); float q = 0.f;
#pragma unroll
    for (int i = 0; i < 16; ++i) { v[i] -= mean; q += v[i] * v[i]; }
    const float rstd = 1.0f / sqrtf(wave_sum(q) * (1.0f / D) + LN_EPS);
#pragma unroll
    for (int i = 0; i < 16; ++i) v[i] = v[i] * rstd * g[i] + b[i];
}

__device__ __forceinline__ void ln_rows2(float (&v)[2][16], const float (&g)[16], const float (&b)[16]) {
    float s0 = 0.f, s1 = 0.f;
#pragma unroll
    for (int i = 0; i < 16; ++i) { s0 += v[0][i]; s1 += v[1][i]; }
#pragma unroll
    for (int o = 1; o < 64; o <<= 1) { s0 += __shfl_xor(s0, o); s1 += __shfl_xor(s1, o); }
    const float m0 = s0 * (1.0f / D), m1 = s1 * (1.0f / D); float q0 = 0.f, q1 = 0.f;
#pragma unroll
    for (int i = 0; i < 16; ++i) { v[0][i] -= m0; v[1][i] -= m1; q0 += v[0][i] * v[0][i]; q1 += v[1][i] * v[1][i]; }
#pragma unroll
    for (int o = 1; o < 64; o <<= 1) { q0 += __shfl_xor(q0, o); q1 += __shfl_xor(q1, o); }
    const float r0 = 1.0f / sqrtf(q0 * (1.0f / D) + LN_EPS), r1 = 1.0f / sqrtf(q1 * (1.0f / D) + LN_EPS);
#pragma unroll
    for (int i = 0; i < 16; ++i) { v[0][i] = v[0][i] * r0 * g[i] + b[i]; v[1][i] = v[1][i] * r1 * g[i] + b[i]; }
}
constexpr int XPITCH = 2064;
constexpr int L_XHI = 0, L_XLO = 16 * XPITCH, L_PART = 2 * 16 * XPITCH  ;
__device__ __forceinline__ void p4_ln1_router(const Frame& F, const Args& a) {
    float* R = a.out; bf16_t* X1B = (bf16_t*)(a.ws + WS_XB1); float* TG = (float*)(a.ws + WS_TG); int* LIST = (int*)(a.ws + WS_LIST);
    unsigned* gcnt = (unsigned*)(a.ws + WS_CTL) + CW_CNT;
    LAS unsigned* lhist = (LAS unsigned*)(F.lds + L_HIST); LAS unsigned* lbase = (LAS unsigned*)(F.lds + L_BASE); LAS unsigned* asg = (LAS unsigned*)(F.lds + L_ASG);
    const int lane = F.lane, w = F.wave, fr = lane & 15, fq = lane >> 4;
    if (F.tid < 32) lhist[F.tid] = 0u;
    float g[16], b[16];
    load_row16(a.ln1_g, lane, g); load_row16(a.ln1_b, lane, b);
    bf16x8 bhi[4][2], blo[4][2];
#pragma unroll
    for (int ks = 0; ks < 4; ++ks)
#pragma unroll
        for (int h = 0; h < 2; ++h) { unsigned hw[4], lw[4];
#pragma unroll
            for (int i2 = 0; i2 < 4; ++i2) { const int k = 128 * w + 32 * ks + 8 * fq + 2 * i2; const float v0 = a.router_w[(size_t)k * NE + 16 * h + fr], v1 = a.router_w[(size_t)(k + 1) * NE + 16 * h + fr];
                const unsigned hp = cvt_pk_bf16(v0, v1); const float r0 = v0 - bf_lo(hp), r1 = v1 - bf_hi(hp); hw[i2] = hp; lw[i2] = cvt_pk_bf16(r0, r1); }
            bhi[ks][h] = __builtin_bit_cast(bf16x8, (u32x4){hw[0], hw[1], hw[2], hw[3]}); blo[ks][h] = __builtin_bit_cast(bf16x8, (u32x4){lw[0], lw[1], lw[2], lw[3]}); }
    const float rbias = a.router_b[F.tid & 31];
    __syncthreads();
    int gl = 0;
    float vn[2][16];
#pragma unroll
    for (int rr = 0; rr < 2; ++rr) load_row16(R + (size_t)(F.vcu * 16 + 2 * w + rr) * D, lane, vn[rr]);
    for (int grp = F.vcu; grp < M / 16; grp += F.G, ++gl) {
        const int row0 = grp * 16;
        float v2[2][16];
#pragma unroll
        for (int rr = 0; rr < 2; ++rr)
#pragma unroll
            for (int i = 0; i < 16; ++i) v2[rr][i] = vn[rr][i];
        if (grp + F.G < M / 16) {
#pragma unroll
            for (int rr = 0; rr < 2; ++rr) load_row16(R + (size_t)((grp + F.G) * 16 + 2 * w + rr) * D, lane, vn[rr]); }
        ln_rows2(v2, g, b);
#pragma unroll
        for (int rr = 0; rr < 2; ++rr) { const int rl = 2 * w + rr; float* rp = R + (size_t)(row0 + rl) * D; float (&v)[16] = v2[rr];
            store_row16(rp, lane, v);
#pragma unroll
            for (int j = 0; j < 2; ++j) { unsigned hw[4], lw[4];
#pragma unroll
                for (int i2 = 0; i2 < 4; ++i2) { const float v0 = v[8 * j + 2 * i2], v1 = v[8 * j + 2 * i2 + 1]; const unsigned hp = cvt_pk_bf16(v0, v1); hw[i2] = hp; lw[i2] = cvt_pk_bf16(v0 - bf_lo(hp), v1 - bf_hi(hp)); }
                const u32x4 hv = {hw[0], hw[1], hw[2], hw[3]}, lv = {lw[0], lw[1], lw[2], lw[3]};
                *(u32x4*)(X1B + (size_t)(row0 + rl) * D + 8 * lane + 512 * j) = hv;
                *(LAS u32x4*)(F.lds + L_XHI + rl * XPITCH + (8 * lane + 512 * j) * 2) = hv; *(LAS u32x4*)(F.lds + L_XLO + rl * XPITCH + (8 * lane + 512 * j) * 2) = lv; } }
        __syncthreads();
        f32x4 acc[2] = {(f32x4){0.f, 0.f, 0.f, 0.f}, (f32x4){0.f, 0.f, 0.f, 0.f}};
#pragma unroll
        for (int ks = 0; ks < 4; ++ks) { const int ko = (128 * w + 32 * ks + 8 * fq) * 2;
            const bf16x8 ahi = *(const LAS bf16x8*)(F.lds + L_XHI + fr * XPITCH + ko), alo = *(const LAS bf16x8*)(F.lds + L_XLO + fr * XPITCH + ko);
#pragma unroll
            for (int h = 0; h < 2; ++h) { acc[h] = __builtin_amdgcn_mfma_f32_16x16x32_bf16(bhi[ks][h], ahi, acc[h], 0, 0, 0); acc[h] = __builtin_amdgcn_mfma_f32_16x16x32_bf16(blo[ks][h], ahi, acc[h], 0, 0, 0);
                acc[h] = __builtin_amdgcn_mfma_f32_16x16x32_bf16(bhi[ks][h], alo, acc[h], 0, 0, 0); } }
#pragma unroll
        for (int h = 0; h < 2; ++h) *(LAS f32x4*)(F.lds + L_PART + ((w * 16 + fr) * 32 + 16 * h + 4 * fq) * 4) = acc[h];
        __syncthreads();
        { const int rl = F.tid >> 5, e = F.tid & 31; float v = rbias;
#pragma unroll
            for (int ww = 0; ww < 8; ++ww) v += *(const LAS float*)(F.lds + L_PART + ((ww * 16 + rl) * 32 + e) * 4);
            bool taken = false; float sv[4]; int si[4];
#pragma unroll
            for (int r = 0; r < 4; ++r) { float bv = taken ? -__builtin_inff() : v; int bi = e;
#pragma unroll
                for (int mk = 1; mk < 32; mk <<= 1) { const float ov = __shfl_xor(bv, mk); const int oi = __shfl_xor(bi, mk); if (ov > bv || (ov == bv && oi < bi)) { bv = ov; bi = oi; } }
                sv[r] = bv; si[r] = bi; if (bi == e) taken = true; }
            const float p1 = __expf(sv[1] - sv[0]), p2 = __expf(sv[2] - sv[0]), p3 = __expf(sv[3] - sv[0]); const float inv = 1.0f / (1.0f + p1 + p2 + p3);
            if (e < 4) { const float gk = (e == 0 ? 1.0f : e == 1 ? p1 : e == 2 ? p2 : p3) * inv; const int ek = e == 0 ? si[0] : e == 1 ? si[1] : e == 2 ? si[2] : si[3];
                TG[(size_t)(row0 + rl) * 4 + e] = gk;
                const unsigned rank = atomicAdd((unsigned*)(lhist + ek), 1u);
                asg[(gl * 16 + rl) * 4 + e] = ((unsigned)ek << 16) | rank; } }
    }
    __syncthreads();
    if (F.tid < 32) lbase[F.tid] = __hip_atomic_fetch_add(gcnt + F.tid, lhist[F.tid], RLX_AGENT);
    __syncthreads();
    for (int s = F.tid; s < gl * 64; s += 512) { const unsigned av = asg[s]; const int e = av >> 16, rank = av & 0xffff; const int g2 = s >> 6, rl = (s >> 2) & 15, k = s & 3;
        const int tok = (F.vcu + g2 * F.G) * 16 + rl; LIST[(size_t)e * LCAP + lbase[e] + rank] = tok * 4 + k; }
}

__device__ __forceinline__ void moe_tables(const Frame& F, const Args& a, int ncol  ) {
    LAS int* tst = (LAS int*)(F.lds + L_TST); LAS int* lcnt = (LAS int*)(F.lds + L_CNT); LAS int* ut = (LAS int*)(F.lds + L_UT);
    unsigned* gcnt = (unsigned*)(a.ws + WS_CTL) + CW_CNT;
    if (F.tid < 32) lcnt[F.tid] = (int)__hip_atomic_load(gcnt + F.tid, RLX_AGENT);
    __syncthreads();
    if (F.tid == 0) { int s = 0; for (int e = 0; e < NE; ++e) { tst[e] = s; s += (lcnt[e] + 255) >> 8; } tst[NE] = s; }
    __syncthreads();
    if (F.tid < 32) { const int i = F.tid; const int T = tst[NE]; const long L = (long)i * F.G + F.vcu; int e = 0, tile = 0, pn = 0, valid = 0, lb = 0, nv = 0;
        if (L < (long)T * ncol) { tile = (int)(L / ncol); pn = (int)(L % ncol); valid = 1; for (int q = 0; q < NE; ++q) if (tst[q + 1] <= tile) e = q + 1;
            const int tin = tile - tst[e]; lb = e * LCAP + tin * 256; nv = lcnt[e] - tin * 256; nv = nv > 256 ? 256 : nv; }
        ut[i * 8 + 0] = e; ut[i * 8 + 1] = tile; ut[i * 8 + 2] = pn; ut[i * 8 + 3] = valid; ut[i * 8 + 4] = lb; ut[i * 8 + 5] = nv; ut[i * 8 + 6] = 0; ut[i * 8 + 7] = 0; }
    __syncthreads();
}

__device__ __forceinline__ void p7_combine_ln2(const Frame& F, const Args& a) {
    float* R = a.out; bf16_t* X2B = (bf16_t*)(a.ws + WS_XB1); const float* TG = (const float*)(a.ws + WS_TG); const bf16_t* Y = (const bf16_t*)(a.ws + WS_Y);
    const int lane = F.lane, gw = F.vcu * 8 + F.wave, NGW = F.G * 8;
    float g[16], b[16]; load_row16(a.ln2_g, lane, g); load_row16(a.ln2_b, lane, b);
    for (int row = 2 * gw; row < M; row += 2 * NGW) { float v[2][16]; u32x4 yw[2][4][2]; f32x4 gt[2];
#pragma unroll
        for (int r = 0; r < 2; ++r) { load_row16(R + (size_t)(row + r) * D, lane, v[r]); gt[r] = *(const f32x4*)(TG + (size_t)(row + r) * 4);
#pragma unroll
            for (int k = 0; k < 4; ++k)
#pragma unroll
                for (int j = 0; j < 2; ++j) yw[r][k][j] = *(const u32x4*)(Y + ((size_t)(row + r) * 4 + k) * D + 8 * lane + 512 * j); }
#pragma unroll
        for (int r = 0; r < 2; ++r) {
#pragma unroll
            for (int i = 0; i < 16; ++i) v[r][i] *= ALPHA;
#pragma unroll
            for (int k = 0; k < 4; ++k)
#pragma unroll
                for (int j = 0; j < 2; ++j) { float f[8]; unpack8(yw[r][k][j], f);
#pragma unroll
                    for (int i = 0; i < 8; ++i) v[r][8 * j + i] += gt[r][k] * f[i]; } }
        ln_rows2(v, g, b);
#pragma unroll
        for (int r = 0; r < 2; ++r) { store_row16(R + (size_t)(row + r) * D, lane, v[r]);
#pragma unroll
            for (int j = 0; j < 2; ++j) { u32x4 o; o.x = cvt_pk_bf16(v[r][8 * j], v[r][8 * j + 1]); o.y = cvt_pk_bf16(v[r][8 * j + 2], v[r][8 * j + 3]); o.z = cvt_pk_bf16(v[r][8 * j + 4], v[r][8 * j + 5]); o.w = cvt_pk_bf16(v[r][8 * j + 6], v[r][8 * j + 7]);
                *(u32x4*)(X2B + (size_t)(row + r) * D + 8 * lane + 512 * j) = o; } } }
}
__device__ __forceinline__ void p9_ln3(const Frame& F, const Args& a) {
    float* R = a.out; const int lane = F.lane, gw = F.vcu * 8 + F.wave, NGW = F.G * 8;
    float g[16], b[16]; load_row16(a.ln3_g, lane, g); load_row16(a.ln3_b, lane, b);
    for (int row = 2 * gw; row < M; row += 2 * NGW) { float v[2][16];
        load_row16(R + (size_t)row * D, lane, v[0]); load_row16(R + (size_t)(row + 1) * D, lane, v[1]);
        ln_rows2(v, g, b);
        store_row16(R + (size_t)row * D, lane, v[0]); store_row16(R + (size_t)(row + 1) * D, lane, v[1]); }
}

__global__ void __launch_bounds__(512, 2) fwd_kernel(Args args) {
    extern __shared__ __attribute__((aligned(16))) unsigned char lds_raw[];
    Frame F;
    F.lds = (LAS unsigned char*)lds_raw;
    F.tid = threadIdx.x; F.lane = F.tid & 63; F.wave = __builtin_amdgcn_readfirstlane(F.tid >> 6);
    F.G = gridDim.x; { const int bx = blockIdx.x; F.vcu = (F.G % 8 == 0) ? (bx % 8) * (F.G / 8) + bx / 8 : bx; }
    unsigned char* ws = args.ws;
    volatile LAS unsigned* MISC = (volatile LAS unsigned*)(F.lds + L_MISC);
    for (int u = F.tid; u < (LDS_BYTES - RING_BYTES) / 4; u += 512) ((LAS unsigned*)(F.lds + RING_BYTES))[u] = 0u;
    __syncthreads();
    XcdBarrier bar; bar.bar = (unsigned*)(ws + WS_CTL) + CW_BAR; bar.x = 0; bar.st = nullptr;
    if (MK_N_LAUNCHES == 1) bar = xcd_barrier_post((unsigned*)(ws + WS_CTL) + CW_BAR, MISC + 8);
    const int lo = args.ph_lo, hi = args.ph_hi;
#ifndef PHASE_MASK
#define PHASE_MASK 0x3ff
#endif
#define IN(k) (((PHASE_MASK >> (k)) & 1) && lo <= (k) && (k) < hi)
#define GRID_BAR(k) do { if (IN(k) && IN((k) + 1)) xcd_barrier(bar); } while (0)

    if (IN(0)) { _Pragma("unroll") for (int rep = 0; rep < REP0; ++rep) p0_prologue(F, args); GRID_BAR(0); }

    if (IN(1)) {
        _Pragma("unroll") for (int rep = 0; rep < REP1; ++rep) {
        { pg8::DenseOrder S; S.init(ws + WS_XB, ws + WS_WIN, M, DIN, D, F.G, (int)blockIdx.x); pg8::EpiBf16 E{(bf16_t*)(ws + WS_PROJ), DIN};
          pg8::gemm_phase<pg8::EpiBf16, pg8::DenseOrder>(F.lds, D, S, E); }
        { pg8::DenseOrder S; S.init(ws + WS_PB, ws + WS_WP, M, D, PLE, F.G, (int)blockIdx.x); pg8::EpiBf16 E{(bf16_t*)(ws + WS_PLE), D};
          pg8::gemm_phase<pg8::EpiBf16, pg8::DenseOrder>(F.lds, PLE, S, E); }
        }
        GRID_BAR(1);
    }

    if (IN(2)) { _Pragma("unroll") for (int rep = 0; rep < REP2; ++rep) p2_mixer(F, args); GRID_BAR(2); }

    if (IN(3)) {
        pg8::DenseOrder S; S.init(ws + WS_A2, ws + WS_W2, M, D, D, F.G, (int)blockIdx.x); pg8::EpiH1 E{args.x, args.out};
        _Pragma("unroll") for (int rep = 0; rep < REP3; ++rep) pg8::gemm_phase<pg8::EpiH1, pg8::DenseOrder>(F.lds, D, S, E);
        GRID_BAR(3);
    }

    if (IN(4)) { p4_ln1_router(F, args); GRID_BAR(4); }

    if (IN(5)) {
        moe_tables(F, args, 8);
        pg8::MoeGuOrder S; S.ut = (const LAS int*)(F.lds + L_UT); S.A = (const char*)(ws + WS_XB1); S.Bt = (const char*)(ws + WS_WGU); S.list = (const int*)(ws + WS_LIST); S.K = D; S.bstride_e = (size_t)2 * FF * D * 2; S.gather = true;
        pg8::EpiGU E{(bf16_t*)(ws + WS_HID), args.b_gu};
        _Pragma("unroll") for (int rep = 0; rep < REP5; ++rep) pg8::gemm_phase<pg8::EpiGU, pg8::MoeGuOrder>(F.lds, D, S, E);
        GRID_BAR(5);
    }

    if (IN(6)) {
        moe_tables(F, args, 4);
        pg8::MoeDnOrder S; S.ut = (const LAS int*)(F.lds + L_UT); S.A = (const char*)(ws + WS_HID); S.Bt = (const char*)(ws + WS_WDN); S.list = (const int*)(ws + WS_LIST); S.K = FF; S.bstride_e = (size_t)D * FF * 2; S.gather = false;
        pg8::EpiDown E{(bf16_t*)(ws + WS_Y), args.b_dn, (const int*)(ws + WS_LIST)};
        _Pragma("unroll") for (int rep = 0; rep < REP6; ++rep) pg8::gemm_phase<pg8::EpiDown, pg8::MoeDnOrder>(F.lds, FF, S, E);
        GRID_BAR(6);
    }

    if (IN(7)) { p7_combine_ln2(F, args); GRID_BAR(7); }

    if (IN(8)) {
        pg8::DenseOrder S; S.init(ws + WS_XB1, ws + WS_WG, M, D, D, F.G, (int)blockIdx.x); pg8::EpiGate E{args.out, (const bf16_t*)(ws + WS_PLE), args.ple_gate_b};
        pg8::gemm_phase<pg8::EpiGate, pg8::DenseOrder>(F.lds, D, S, E);
        GRID_BAR(8);
    }

    if (IN(9)) { p9_ln3(F, args); }
#undef IN
#undef GRID_BAR
}

extern "C" void kernel_launch(void* const* d_in, const int* in_sizes, int n_in, void* d_out, int out_size, void* d_ws, size_t ws_size, hipStream_t stream) {
    static int grid = 0;
    if (grid == 0) {
        if (n_in != 22 || in_sizes[0] != M * D || out_size != M * D || ws_size < WS_END) { fprintf(stderr, "kernel_launch: unexpected shapes (n_in %d, in0 %d, out %d, ws %zu); nothing launched\n", n_in, n_in > 0 ? in_sizes[0] : -1, out_size, ws_size); grid = -1; return; }
        int dev = 0, cus = 0, per_cu = 0;
        if (hipGetDevice(&dev) != hipSuccess || hipDeviceGetAttribute(&cus, hipDeviceAttributeMultiprocessorCount, dev) != hipSuccess) { grid = -1; return; }
        if (hipFuncSetAttribute((const void*)fwd_kernel, hipFuncAttributeMaxDynamicSharedMemorySize, LDS_BYTES) != hipSuccess) { fprintf(stderr, "kernel_launch: hipFuncSetAttribute failed\n"); grid = -1; return; }
        if (hipOccupancyMaxActiveBlocksPerMultiprocessor(&per_cu, (const void*)fwd_kernel, 512, LDS_BYTES) != hipSuccess || per_cu < 1) fprintf(stderr, "kernel_launch: occupancy query reports %d\n", per_cu);
        (void)hipGetLastError();
        grid = cus;
        if (grid != 256) fprintf(stderr, "kernel_launch: %d CUs (expected 256)\n", grid);
    }
    if (grid < 0) return;
    (void)hipMemsetAsync((char*)d_ws + WS_CTL, 0, CTL_ZERO_BYTES, stream);
    Args a{};
    const float** ap = (const float**)&a;
    for (int i = 0; i < 22; ++i) ap[i] = (const float*)d_in[i];
    a.out = (float*)d_out; a.ws = (unsigned char*)d_ws;
#if MK_N_LAUNCHES == 1
    a.ph_lo = 0; a.ph_hi = NPHASE;
    hipLaunchKernelGGL(fwd_kernel, dim3(grid), dim3(512), LDS_BYTES, stream, a);
#else
    for (int ph = 0; ph < NPHASE; ++ph) { a.ph_lo = ph; a.ph_hi = ph + 1; hipLaunchKernelGGL(fwd_kernel, dim3(grid), dim3(512), LDS_BYTES, stream, a); }
#endif
}
```

```cpp
#include <hip/hip_runtime.h>
#include <cstdio>
#include <cstdint>

#ifndef MK_N_LAUNCHES
#define MK_N_LAUNCHES 1
#endif

#ifndef REP0
#define REP0 1
#endif
#ifndef REP1
#define REP1 1
#endif
#ifndef REP2
#define REP2 1
#endif
#ifndef REP3
#define REP3 1
#endif
#ifndef REP5
#define REP5 1
#endif
#ifndef REP6
#define REP6 1
#endif
#define LAS __attribute__((address_space(3)))
#define GAS __attribute__((address_space(1)))
typedef unsigned short bf16_t;
typedef short bf16x8 __attribute__((ext_vector_type(8)));
typedef float f32x4 __attribute__((ext_vector_type(4)));
typedef float f32x2 __attribute__((ext_vector_type(2)));
typedef unsigned u32x4 __attribute__((ext_vector_type(4)));
typedef unsigned u32x2 __attribute__((ext_vector_type(2)));
typedef GAS unsigned gu32;

constexpr int M = 32768, D = 1024, SEQ = 4096, DIN = 2048, NE = 32, TOPK = 4, FF = 1024, PLE = 256, DPOOL = 512;
constexpr int NA = M * TOPK;
constexpr int LCAP = M;
constexpr int MAXTILES = NA / 256 + NE;
constexpr float ALPHA = 1.189207115002721f;
constexpr float LN_EPS = 1e-5f;
constexpr float SW_LIMIT = 7.0f, SW_ALPHA = 1.702f;
constexpr int NPHASE = 10;

constexpr size_t MiB = 1u << 20;
constexpr size_t WS_CTL = 0, CTL_ZERO_BYTES = 1 * MiB;
constexpr size_t WS_WIN = 1 * MiB;
constexpr size_t WS_W2 = 5 * MiB;
constexpr size_t WS_WG = 7 * MiB;
constexpr size_t WS_WP = 9 * MiB;
constexpr size_t WS_TG = 10 * MiB;
constexpr size_t WS_LIST = 11 * MiB;
constexpr size_t WS_WGU = 16 * MiB;
constexpr size_t WS_WDN = 144 * MiB;
constexpr size_t WS_XB1 = 208 * MiB;
constexpr size_t WS_PLE = 272 * MiB;
constexpr size_t WS_HID = 336 * MiB;
constexpr size_t WS_PROJ = 336 * MiB;
constexpr size_t WS_A2 = 464 * MiB;
constexpr size_t WS_XB = 528 * MiB;
constexpr size_t WS_PB = 592 * MiB;
constexpr size_t WS_H3 = 336 * MiB;
constexpr size_t WS_Y = 608 * MiB;
constexpr size_t WS_END = 864 * MiB;
static_assert(WS_HID + (size_t)MAXTILES * 256 * 1024 * 2 <= WS_Y, "hidden fits");
constexpr int CW_TMO = 0, CW_CODE = 1, CW_CNT = 64  , CW_BAR = 4096;

constexpr int RING_BYTES = 131072;
constexpr int L_MISC = RING_BYTES;
constexpr int L_TST = RING_BYTES + 128;
constexpr int L_CNT = RING_BYTES + 272;
constexpr int L_UT = RING_BYTES + 640;
constexpr int L_HIST = RING_BYTES + 1664;
constexpr int L_BASE = RING_BYTES + 1792;
constexpr int L_ASG = RING_BYTES + 2048;
constexpr int LDS_BYTES = 147456;
static_assert(L_ASG + 2048 <= LDS_BYTES, "LDS map");

#define RLX_AGENT __ATOMIC_RELAXED, __HIP_MEMORY_SCOPE_AGENT
#define LDS_WAIT() asm volatile("s_waitcnt lgkmcnt(0)" ::: "memory")
#define VM_WAIT() asm volatile("s_waitcnt vmcnt(0)" ::: "memory")

__device__ __forceinline__ unsigned cvt_pk_bf16(float lo, float hi) { unsigned r; asm volatile("v_cvt_pk_bf16_f32 %0, %1, %2" : "=v"(r) : "v"(lo), "v"(hi)); return r; }
__device__ __forceinline__ float bf_lo(unsigned w) { return __uint_as_float(w << 16); }
__device__ __forceinline__ float bf_hi(unsigned w) { return __uint_as_float(w & 0xffff0000u); }
__device__ __forceinline__ float wave_sum(float v) {
#pragma unroll
    for (int o = 1; o < 64; o <<= 1) v += __shfl_xor(v, o);
    return v;
}

namespace pg8 {
constexpr int BM = 256, BK = 64, HALF = 128, HTB = HALF * BK * 2, STAGE_BYTES = 8 * HTB, NXCD = 8, WGM = 8;
__host__ __device__ __forceinline__ int lds_byte(int r, int c) { const int st = (r >> 4) * 2 + (c >> 5), rr = r & 15, cc = c & 31, ob = rr * 64 + cc * 2; return st * 1024 + (ob ^ (((ob >> 9) & 1) << 5)); }
__host__ __device__ __forceinline__ void stage_rc(int b, int& R, int& C) { const int st = b / 1024, sb = b % 1024, swz = sb ^ (((sb >> 9) & 1) << 5); R = (st >> 1) * 16 + swz / 64; C = (st & 1) * 32 + (swz % 64) / 2; }
__host__ __device__ __forceinline__ int perm32(int rho) { const int n = rho >> 4, i = rho & 15; return 8 * (i >> 2) + 4 * n + (i & 3); }

struct Unit { const char* A; const char* B; int pm, pn, e, lbase, nvalid; };

struct DenseOrder {
    static constexpr bool GATHER = false;
    const char* A; const char* Bt; int K, nM, nN, nwg, G, c;
    __device__ __forceinline__ void init(const void* A_, const void* Bt_, int M_, int N_, int K_, int G_, int c_) { A = (const char*)A_; Bt = (const char*)Bt_; K = K_; nM = M_ / BM; nN = N_ / BM; nwg = nM * nN; G = G_; c = c_; }
    __device__ __forceinline__ bool next(int i, Unit& u) const {
        const long L = (long)i * G + c; if (L >= nwg) return false;
        int wgid = (int)L; { const int q = nwg / NXCD, r = nwg % NXCD, xcd = wgid % NXCD, off = wgid / NXCD; wgid = (xcd < r ? xcd * (q + 1) : r * (q + 1) + (xcd - r) * q) + off; }
        const int nig = WGM * nN, gid = wgid / nig, fm = gid * WGM, gsz = (nM - fm) < WGM ? (nM - fm) : WGM;
        u.pm = fm + ((wgid % nig) % gsz); u.pn = (wgid % nig) / gsz;
        u.A = A + (size_t)u.pm * BM * K * 2; u.B = Bt + (size_t)u.pn * BM * K * 2; u.e = 0; u.lbase = 0; u.nvalid = BM; return true;
    }
    __device__ __forceinline__ void rows(const Unit&, int R0, unsigned (&off)[4]) const {
#pragma unroll
        for (int j = 0; j < 4; ++j) off[j] = (unsigned)((R0 + 64 * j) * K * 2);
    }
};

struct MoeOrder {
    const LAS int* ut; const char* A; const char* Bt; const int* list; int K; size_t bstride_e; bool gather;
    __device__ __forceinline__ bool next_(int i, Unit& u) const {
        if (i >= 32) return false;
        const LAS int* t = ut + i * 8;
        const int e = __builtin_amdgcn_readfirstlane(t[0]), tile = __builtin_amdgcn_readfirstlane(t[1]), pn = __builtin_amdgcn_readfirstlane(t[2]), valid = __builtin_amdgcn_readfirstlane(t[3]);
        const int lb = __builtin_amdgcn_readfirstlane(t[4]), nv = __builtin_amdgcn_readfirstlane(t[5]);
        if (!valid) return false;
        u.e = e; u.pm = tile; u.pn = pn; u.lbase = lb; u.nvalid = nv;
        u.B = Bt + (size_t)e * bstride_e + (size_t)pn * BM * K * 2;
        u.A = gather ? A : A + (size_t)tile * BM * K * 2;
        return true;
    }
};
struct MoeGuOrder : MoeOrder {
    static constexpr bool GATHER = true;
    __device__ __forceinline__ bool next(int i, Unit& u) const { return next_(i, u); }
    __device__ __forceinline__ void rows(const Unit& u, int R0, unsigned (&off)[4]) const {
#pragma unroll
        for (int j = 0; j < 4; ++j) { const int r = R0 + 64 * j; int aid = 0; if (r < u.nvalid) aid = list[u.lbase + r]; off[j] = (unsigned)(aid >> 2) * (unsigned)(K * 2); }
    }
};
struct MoeDnOrder : MoeOrder {
    static constexpr bool GATHER = false;
    __device__ __forceinline__ bool next(int i, Unit& u) const { return next_(i, u); }
    __device__ __forceinline__ void rows(const Unit&, int R0, unsigned (&off)[4]) const {
#pragma unroll
        for (int j = 0; j < 4; ++j) off[j] = (unsigned)((R0 + 64 * j) * K * 2);
    }
};

struct EpiBf16 {
    static constexpr bool PERM = true;
    bf16_t* O; int ldc;
    __device__ __forceinline__ void operator()(const f32x4 (&acc)[2][2][4][2], const Unit& u, int wr, int wc, int fr, int fq) const {
        const int row0 = u.pm * BM + wr * 64 + fr, col0 = u.pn * BM + wc * 32 + 8 * fq;
#pragma unroll
        for (int ai = 0; ai < 2; ++ai)
#pragma unroll
            for (int m = 0; m < 4; ++m) { bf16_t* rowp = O + (size_t)(row0 + ai * HALF + m * 16) * ldc + col0;
#pragma unroll
                for (int bj = 0; bj < 2; ++bj) { const f32x4 v0 = acc[ai][bj][m][0], v1 = acc[ai][bj][m][1];
                    u32x4 w; w.x = cvt_pk_bf16(v0[0], v0[1]); w.y = cvt_pk_bf16(v0[2], v0[3]); w.z = cvt_pk_bf16(v1[0], v1[1]); w.w = cvt_pk_bf16(v1[2], v1[3]);
                    *(u32x4*)(rowp + bj * HALF) = w; } }
    }
};
struct EpiH1 {
    static constexpr bool PERM = true;
    const bf16_t* xb; bf16_t* H1;
    __device__ __forceinline__ void operator()(const f32x4 (&acc)[2][2][4][2], const Unit& u, int wr, int wc, int fr, int fq) const {
        const int row0 = u.pm * BM + wr * 64 + fr, col0 = u.pn * BM + wc * 32 + 8 * fq;
#pragma unroll
        for (int ai = 0; ai < 2; ++ai)
#pragma unroll
            for (int m = 0; m < 4; ++m) { const size_t off = (size_t)(row0 + ai * HALF + m * 16) * D + col0;
#pragma unroll
                for (int bj = 0; bj < 2; ++bj) { const u32x4 xw = *(const u32x4*)(xb + off + bj * HALF); const f32x4 v0 = acc[ai][bj][m][0], v1 = acc[ai][bj][m][1];
                    u32x4 w; w.x = cvt_pk_bf16(bf_lo(xw.x) * ALPHA + v0[0], bf_hi(xw.x) * ALPHA + v0[1]); w.y = cvt_pk_bf16(bf_lo(xw.y) * ALPHA + v0[2], bf_hi(xw.y) * ALPHA + v0[3]);
                    w.z = cvt_pk_bf16(bf_lo(xw.z) * ALPHA + v1[0], bf_hi(xw.z) * ALPHA + v1[1]); w.w = cvt_pk_bf16(bf_lo(xw.w) * ALPHA + v1[2], bf_hi(xw.w) * ALPHA + v1[3]);
                    *(u32x4*)(H1 + off + bj * HALF) = w; }
                asm volatile("" ::: "memory"); }
    }
};
struct EpiGU {
    static constexpr bool PERM = true;
    bf16_t* H; const float* bgu;
    __device__ __forceinline__ void operator()(const f32x4 (&acc)[2][2][4][2], const Unit& u, int wr, int wc, int fr, int fq) const {
        const int row0 = u.pm * BM + wr * 64 + fr, cc = u.pn * HALF + wc * 32 + 8 * fq;
        const float* bp = bgu + (size_t)u.e * (2 * FF) + cc;
        f32x4 bg[2], bu[2];
#pragma unroll
        for (int n = 0; n < 2; ++n) { bg[n] = *(const f32x4*)(bp + 4 * n); bu[n] = *(const f32x4*)(bp + FF + 4 * n); }
#pragma unroll
        for (int ai = 0; ai < 2; ++ai)
#pragma unroll
            for (int m = 0; m < 4; ++m) { bf16_t* rowp = H + (size_t)(row0 + ai * HALF + m * 16) * FF + cc; float h[8];
#pragma unroll
                for (int n = 0; n < 2; ++n)
#pragma unroll
                    for (int i = 0; i < 4; ++i) {
                        const float g = fminf(acc[ai][0][m][n][i] + bg[n][i], SW_LIMIT);
                        const float up = fminf(fmaxf(acc[ai][1][m][n][i] + bu[n][i], -SW_LIMIT), SW_LIMIT);
                        const float sg = __builtin_amdgcn_rcpf(1.0f + __builtin_amdgcn_exp2f(g * (-SW_ALPHA * 1.4426950408889634f)));
                        h[4 * n + i] = (up + 1.0f) * (g * sg); }
                u32x4 w; w.x = cvt_pk_bf16(h[0], h[1]); w.y = cvt_pk_bf16(h[2], h[3]); w.z = cvt_pk_bf16(h[4], h[5]); w.w = cvt_pk_bf16(h[6], h[7]);
                *(u32x4*)rowp = w; }
    }
};
struct EpiDown {
    static constexpr bool PERM = true;
    bf16_t* Y; const float* bdn; const int* list;
    __device__ __forceinline__ void operator()(const f32x4 (&acc)[2][2][4][2], const Unit& u, int wr, int wc, int fr, int fq) const {
        const int col0 = u.pn * BM + wc * 32 + 8 * fq;
        const float* bp = bdn + (size_t)u.e * D + col0;
        f32x4 bv[2][2];
#pragma unroll
        for (int bj = 0; bj < 2; ++bj)
#pragma unroll
            for (int n = 0; n < 2; ++n) bv[bj][n] = *(const f32x4*)(bp + bj * HALF + 4 * n);
#pragma unroll
        for (int ai = 0; ai < 2; ++ai)
#pragma unroll
            for (int m = 0; m < 4; ++m) { const int r = ai * HALF + wr * 64 + m * 16 + fr;
                if (r < u.nvalid) { const int aid = list[u.lbase + r]; bf16_t* rowp = Y + (size_t)aid * D + col0;
#pragma unroll
                    for (int bj = 0; bj < 2; ++bj) { const f32x4 v0 = acc[ai][bj][m][0] + bv[bj][0], v1 = acc[ai][bj][m][1] + bv[bj][1];
                        u32x4 w; w.x = cvt_pk_bf16(v0[0], v0[1]); w.y = cvt_pk_bf16(v0[2], v0[3]); w.z = cvt_pk_bf16(v1[0], v1[1]); w.w = cvt_pk_bf16(v1[2], v1[3]);
                        *(u32x4*)(rowp + bj * HALF) = w; } } }
    }
};
struct EpiGate {
    static constexpr bool PERM = true;
    const bf16_t* x2b; const bf16_t* ple; const float* bg; bf16_t* H3;
    __device__ __forceinline__ void operator()(const f32x4 (&acc)[2][2][4][2], const Unit& u, int wr, int wc, int fr, int fq) const {
        const int row0 = u.pm * BM + wr * 64 + fr, col0 = u.pn * BM + wc * 32 + 8 * fq;
        f32x4 bv[2][2];
#pragma unroll
        for (int bj = 0; bj < 2; ++bj)
#pragma unroll
            for (int n = 0; n < 2; ++n) bv[bj][n] = *(const f32x4*)(bg + col0 + bj * HALF + 4 * n);
#pragma unroll
        for (int ai = 0; ai < 2; ++ai)
#pragma unroll
            for (int m = 0; m < 4; ++m) { const size_t off = (size_t)(row0 + ai * HALF + m * 16) * D + col0;
#pragma unroll
                for (int bj = 0; bj < 2; ++bj) { const u32x4 xw = *(const u32x4*)(x2b + off + bj * HALF), pw = *(const u32x4*)(ple + off + bj * HALF);
                    const float xs[8] = {bf_lo(xw.x), bf_hi(xw.x), bf_lo(xw.y), bf_hi(xw.y), bf_lo(xw.z), bf_hi(xw.z), bf_lo(xw.w), bf_hi(xw.w)};
                    const float ps[8] = {bf_lo(pw.x), bf_hi(pw.x), bf_lo(pw.y), bf_hi(pw.y), bf_lo(pw.z), bf_hi(pw.z), bf_lo(pw.w), bf_hi(pw.w)};
                    float r[8];
#pragma unroll
                    for (int n = 0; n < 2; ++n)
#pragma unroll
                        for (int i = 0; i < 4; ++i) { const float z = acc[ai][bj][m][n][i] + bv[bj][n][i]; const float sg = __builtin_amdgcn_rcpf(1.0f + __builtin_amdgcn_exp2f(z * -1.4426950408889634f)); r[4 * n + i] = xs[4 * n + i] * ALPHA + sg * ps[4 * n + i]; }
                    u32x4 w; w.x = cvt_pk_bf16(r[0], r[1]); w.y = cvt_pk_bf16(r[2], r[3]); w.z = cvt_pk_bf16(r[4], r[5]); w.w = cvt_pk_bf16(r[6], r[7]);
                    *(u32x4*)(H3 + off + bj * HALF) = w; }
                asm volatile("" ::: "memory"); }
    }
};

template <class Epi, class Sched>
__device__ __forceinline__ void gemm_phase(LAS unsigned char* lds, const int K, const Sched& S, const Epi& E) {
    const int tid = threadIdx.x, wid = __builtin_amdgcn_readfirstlane(tid >> 6), lane = tid & 63, wr = wid >> 2, wc = wid & 3, fr = lane & 15, fq = lane >> 4;
    const int nt = K / BK;
    int R0, C0; stage_rc(tid * 16, R0, C0);
    unsigned voffB[2];
#pragma unroll
    for (int i = 0; i < 2; ++i) { const int R = R0 + 64 * i; const int Rb = Epi::PERM ? ((R & ~31) + perm32(R & 31)) : R; voffB[i] = (unsigned)(Rb * K + C0) * 2u; }
    const unsigned coff = (unsigned)C0 * 2u;
    const size_t kstep = (size_t)(BK * 2);
    const size_t hstep = (size_t)HALF * K * 2;
    const unsigned ldsw = (unsigned)wid * 1024u;
    const int aoff = lds_byte(wr * 64 + fr, fq * 8), boff = lds_byte(wc * 32 + fr, fq * 8);
#define PG8_SA(b, h) (((b) * 2 + (h)) * HTB)
#define PG8_SB(b, h) ((4 + (b) * 2 + (h)) * HTB)
#define PG8_STAGE_B(bufoff, gbase) do { _Pragma("unroll") for (int _i = 0; _i < 2; ++_i) \
        __builtin_amdgcn_global_load_lds((const unsigned*)((const char*)(gbase) + voffB[_i]), (LAS unsigned*)(lds + (bufoff) + ldsw + _i * 8192), 16, 0, 0); } while (0)
#define PG8_STAGE_A(bufoff, gbase, off, h) do { _Pragma("unroll") for (int _i = 0; _i < 2; ++_i) \
        __builtin_amdgcn_global_load_lds((const unsigned*)((const char*)(gbase) + (off)[2 * (h) + _i]), (LAS unsigned*)(lds + (bufoff) + ldsw + _i * 8192), 16, 0, 0); } while (0)
#define PG8_LDA(dst, b, h) do { _Pragma("unroll") for (int m = 0; m < 4; ++m) _Pragma("unroll") for (int k = 0; k < 2; ++k) dst[m][k] = *(const LAS bf16x8*)(lds + PG8_SA(b, h) + aoff + m * 2048 + k * 1024); } while (0)
#define PG8_LDB(dst, b, h) do { _Pragma("unroll") for (int n = 0; n < 2; ++n) _Pragma("unroll") for (int k = 0; k < 2; ++k) dst[n][k] = *(const LAS bf16x8*)(lds + PG8_SB(b, h) + boff + n * 2048 + k * 1024); } while (0)
#define PG8_MMA(ai, bj, At, Bt) do { __builtin_amdgcn_s_setprio(1); _Pragma("unroll") for (int m = 0; m < 4; ++m) _Pragma("unroll") for (int n = 0; n < 2; ++n) _Pragma("unroll") for (int k = 0; k < 2; ++k) \
        acc[ai][bj][m][n] = __builtin_amdgcn_mfma_f32_16x16x32_bf16(Bt[n][k], At[m][k], acc[ai][bj][m][n], 0, 0, 0); __builtin_amdgcn_s_setprio(0); } while (0)
#define PG8_WAIT_V(n) asm volatile("s_waitcnt vmcnt(" #n ")" ::: "memory")
#define PG8_WAIT_L(n) asm volatile("s_waitcnt lgkmcnt(" #n ")" ::: "memory")
#define PG8_BAR __builtin_amdgcn_s_barrier()
#define PG8_SCHED __builtin_amdgcn_sched_barrier(0)
#define PG8_PIN4(o) asm volatile("" : "+v"((o)[0]), "+v"((o)[1]), "+v"((o)[2]), "+v"((o)[3]))
    Unit cur, nxt, nn; int ui = 0;
    if (!S.next(0, cur)) return;
    bool has_next = S.next(1, nxt);
    unsigned offc[4], offn[4], offnn[4];
    S.rows(cur, R0, offc);
    if (has_next) S.rows(nxt, R0, offn); else { _Pragma("unroll") for (int j = 0; j < 4; ++j) offn[j] = offc[j]; }
#pragma unroll
    for (int j = 0; j < 4; ++j) { offc[j] += coff; if (has_next) offn[j] += coff; else offn[j] = offc[j]; }
    if constexpr (Sched::GATHER) { PG8_PIN4(offc); PG8_PIN4(offn); }
    f32x4 acc[2][2][4][2];
#pragma unroll
    for (int a = 0; a < 2; ++a)
#pragma unroll
        for (int b = 0; b < 2; ++b)
#pragma unroll
            for (int m = 0; m < 4; ++m)
#pragma unroll
                for (int n = 0; n < 2; ++n) acc[a][b][m][n] = (f32x4){0.f, 0.f, 0.f, 0.f};
    bf16x8 At[4][2], B0[2][2], B1[2][2];
    const char* cA = cur.A; const char* cB = cur.B;
    PG8_STAGE_B(PG8_SB(0, 0), cB); PG8_STAGE_B(PG8_SB(0, 1), cB + hstep); PG8_STAGE_A(PG8_SA(0, 0), cA, offc, 0); PG8_STAGE_A(PG8_SA(0, 1), cA, offc, 1);
    if (wr == 1) PG8_BAR;
    PG8_WAIT_V(2); PG8_BAR;
    PG8_STAGE_B(PG8_SB(1, 0), cB + kstep); PG8_STAGE_A(PG8_SA(1, 0), cA + kstep, offc, 0); PG8_STAGE_B(PG8_SB(1, 1), cB + hstep + kstep);
    PG8_WAIT_V(6); PG8_BAR;
    for (;;) {
        const char* nA = has_next ? nxt.A : cA; const char* nB = has_next ? nxt.B : cB;
        for (int t = 0; t < nt; t += 2) {
            const bool last = (t == nt - 2);
            const char* a1 = cA + (size_t)(t + 1) * kstep;
            const char* a2 = last ? nA : cA + (size_t)(t + 2) * kstep; const char* b2 = last ? nB : cB + (size_t)(t + 2) * kstep;
            const char* a3 = a2 + kstep; const char* b3 = b2 + kstep;
            unsigned o2[4];
#pragma unroll
            for (int j = 0; j < 4; ++j) o2[j] = Sched::GATHER ? (last ? offn[j] : offc[j]) : offc[j];
            PG8_LDB(B0, 0, 0); PG8_LDB(B1, 0, 1); PG8_SCHED; PG8_LDA(At, 0, 0); PG8_STAGE_A(PG8_SA(1, 1), a1, offc, 1);
            PG8_WAIT_V(8); PG8_WAIT_L(0); PG8_BAR; PG8_MMA(0, 0, At, B0); PG8_MMA(0, 1, At, B1); PG8_BAR; PG8_SCHED;
            PG8_LDA(At, 0, 1); PG8_STAGE_B(PG8_SB(0, 0), b2); PG8_STAGE_B(PG8_SB(0, 1), b2 + hstep); PG8_STAGE_A(PG8_SA(0, 0), a2, o2, 0);
            PG8_WAIT_V(8); PG8_WAIT_L(0); PG8_BAR; PG8_MMA(1, 0, At, B0); PG8_MMA(1, 1, At, B1); PG8_BAR; PG8_SCHED;
            PG8_LDB(B0, 1, 0); PG8_LDB(B1, 1, 1); PG8_SCHED; PG8_LDA(At, 1, 0); PG8_STAGE_A(PG8_SA(0, 1), a2, o2, 1);
            PG8_WAIT_V(8); PG8_WAIT_L(0); PG8_BAR; PG8_MMA(0, 0, At, B0); PG8_MMA(0, 1, At, B1); PG8_BAR; PG8_SCHED;
            PG8_LDA(At, 1, 1); PG8_STAGE_B(PG8_SB(1, 0), b3); PG8_STAGE_B(PG8_SB(1, 1), b3 + hstep); PG8_STAGE_A(PG8_SA(1, 0), a3, o2, 0);
            PG8_WAIT_V(8); PG8_WAIT_L(0); PG8_BAR; PG8_MMA(1, 0, At, B0); PG8_MMA(1, 1, At, B1); PG8_BAR; PG8_SCHED;
        }
        if (wr == 0) PG8_BAR;
        bool has2 = false;
        if (has_next) { has2 = S.next(ui + 2, nn); if (has2) { S.rows(nn, R0, offnn); } }
        { int fr_e = fr, fq_e = fq; asm volatile("" : "+v"(fr_e), "+v"(fq_e));
          E(acc, cur, wr, wc, fr_e, fq_e); }
        if (!has_next) break;
#pragma unroll
        for (int a = 0; a < 2; ++a)
#pragma unroll
            for (int b = 0; b < 2; ++b)
#pragma unroll
                for (int m = 0; m < 4; ++m)
#pragma unroll
                    for (int n = 0; n < 2; ++n) acc[a][b][m][n] = (f32x4){0.f, 0.f, 0.f, 0.f};
        cur = nxt; cA = nA; cB = nB; ++ui;
#pragma unroll
        for (int j = 0; j < 4; ++j) { offc[j] = offn[j]; if (has2) offn[j] = offnn[j] + coff; }
        if (has2) nxt = nn;
        has_next = has2;
        if constexpr (Sched::GATHER) { PG8_PIN4(offn); }
        if (wr == 1) PG8_BAR;
    }
    PG8_WAIT_V(0);
    PG8_BAR;
#undef PG8_SA
#undef PG8_SB
#undef PG8_STAGE_A
#undef PG8_STAGE_B
#undef PG8_LDA
#undef PG8_LDB
#undef PG8_MMA
#undef PG8_WAIT_V
#undef PG8_WAIT_L
#undef PG8_BAR
#undef PG8_SCHED
#undef PG8_PIN4
}
}

#define XB_TMO      128
#define XB_XCNT(j)  (256  + 64 * (j))
#define XB_XSUB(j)  (1280 + 64 * (j))
#define XB_XGEN(j)  (2304 + 64 * (j))
#define XB_TOP      3328
#define XB_TOPGEN   3392
#define XCD_BAR_WORDS 3456
#define XB_SPIN_CAP (1u << 18)
__device__ __forceinline__ unsigned xb_ld(unsigned* p)              { return __hip_atomic_load(p, __ATOMIC_RELAXED, __HIP_MEMORY_SCOPE_AGENT); }
__device__ __forceinline__ unsigned xb_add(unsigned* p, unsigned v) { return __hip_atomic_fetch_add(p, v, __ATOMIC_RELAXED, __HIP_MEMORY_SCOPE_AGENT); }
__device__ __forceinline__ unsigned xb_xcc_id() { return (unsigned)__builtin_amdgcn_s_getreg((3 << 11) | 20) & 0xFu; }
#define XB_SPIN(cond, bar) do { unsigned _sp = 0; while (cond) { __builtin_amdgcn_s_sleep(1); \
    if ((++_sp & 255u) == 0u) { if (xb_ld(&(bar)[XB_TMO])) break; if (_sp > XB_SPIN_CAP) { atomicAdd(&(bar)[XB_TMO], 1u); break; } } } } while (0)
struct XcdBarrier { unsigned* bar; unsigned x; volatile LAS unsigned* st; };
__device__ __forceinline__ XcdBarrier xcd_barrier_post(unsigned* bar, volatile LAS unsigned* st) {
    XcdBarrier b; b.bar = bar; b.x = xb_xcc_id(); b.st = st;
    if (threadIdx.x == 0) (void)xb_add(&bar[XB_XCNT(b.x)], 1u);
    return b;
}
__device__ __forceinline__ void xcd_barrier_complete(unsigned* bar, unsigned x, unsigned& nloc, unsigned& nx) {
    const unsigned G = gridDim.x * gridDim.y * gridDim.z;
    unsigned sum, cnt, mine, sp = 0u;
    for (;;) {
        sum = 0u; cnt = 0u; mine = 0u;
#pragma unroll
        for (unsigned j = 0; j < 16; ++j) { const unsigned c = xb_ld(&bar[XB_XCNT(j)]); sum += c; cnt += (c > 0u) ? 1u : 0u; mine = (j == x) ? c : mine; }
        if (sum == G) break;
        __builtin_amdgcn_s_sleep(1);
        if ((++sp & 255u) == 0u) { if (xb_ld(&bar[XB_TMO])) break; if (sp > XB_SPIN_CAP) { atomicAdd(&bar[XB_TMO], 1u); break; } }
    }
    nloc = mine > 0u ? mine : 1u; nx = cnt > 0u ? cnt : 1u;
}
__device__ __forceinline__ void xcd_barrier(const XcdBarrier& b) {
    asm volatile("s_waitcnt vmcnt(0)" ::: "memory");
    __syncthreads();
    if (threadIdx.x == 0) {
        unsigned* bar = b.bar;
        __builtin_amdgcn_s_waitcnt(0);
        unsigned nloc = b.st[0], nx = b.st[1];
        if (nloc == 0u) { xcd_barrier_complete(bar, b.x, nloc, nx); b.st[0] = nloc; b.st[1] = nx; }
        const unsigned old = xb_add(&bar[XB_XSUB(b.x)], 1u);
        const unsigned gen = old / nloc;
        if (old + 1u == (gen + 1u) * nloc) {
            __builtin_amdgcn_fence(__ATOMIC_RELEASE, "agent");
            asm volatile("s_waitcnt vmcnt(0)" ::: "memory");
            const unsigned og = xb_add(&bar[XB_TOP], 1u);
            const unsigned tg = og / nx;
            if (og + 1u == (tg + 1u) * nx) xb_add(&bar[XB_TOPGEN], 1u);
            else XB_SPIN(xb_ld(&bar[XB_TOPGEN]) == tg, bar);
            __builtin_amdgcn_fence(__ATOMIC_ACQUIRE, "agent");
            xb_add(&bar[XB_XGEN(b.x)], 1u);
            asm volatile("s_waitcnt vmcnt(0)" ::: "memory");
        } else {
            XB_SPIN(xb_ld(&bar[XB_XGEN(b.x)]) == gen, bar);
            __builtin_amdgcn_fence(__ATOMIC_ACQUIRE, "agent");
            asm volatile("s_waitcnt vmcnt(0)" ::: "memory");
        }
    }
    __syncthreads();
}

struct Args {
    const float* x; const float* p; const float* w_in; const float* pool_mix; const float* pool_scale; const float* conv_w; const float* w_out;
    const float* ln1_g; const float* ln1_b; const float* router_w; const float* router_b; const float* w_gu; const float* b_gu; const float* w_dn; const float* b_dn;
    const float* ln2_g; const float* ln2_b; const float* ple_proj; const float* ple_gate_w; const float* ple_gate_b; const float* ln3_g; const float* ln3_b;
    float* out; unsigned char* ws; int ph_lo, ph_hi;
};
struct Frame { LAS unsigned char* lds; int tid, lane, wave, vcu, G; };

__device__ __forceinline__ void tr_item(const float* src, int ld_src, bf16_t* dst, int ld_dst, LAS float* scr, int lane) {
    const int kr = lane >> 3, nq = lane & 7;
    f32x4 v[8];
#pragma unroll
    for (int r = 0; r < 8; ++r) v[r] = *(const f32x4*)(src + (size_t)(8 * r + kr) * ld_src + 4 * nq);
#pragma unroll
    for (int r = 0; r < 8; ++r)
#pragma unroll
        for (int q = 0; q < 4; ++q) scr[(8 * r + kr) * 33 + 4 * nq + q] = v[r][q];
    LDS_WAIT(); asm volatile("" ::: "memory");
    const int c = lane & 7;
#pragma unroll
    for (int j = 0; j < 4; ++j) { const int n = (lane >> 3) + 8 * j; const LAS float* s = scr + (8 * c) * 33 + n;
        u32x4 o; o.x = cvt_pk_bf16(s[0 * 33], s[1 * 33]); o.y = cvt_pk_bf16(s[2 * 33], s[3 * 33]); o.z = cvt_pk_bf16(s[4 * 33], s[5 * 33]); o.w = cvt_pk_bf16(s[6 * 33], s[7 * 33]);
        *(u32x4*)(dst + (size_t)n * ld_dst + 8 * c) = o; }
    LDS_WAIT(); asm volatile("" ::: "memory");
}
__device__ __forceinline__ void fold_item(const Args& a, bf16_t* W2T, LAS float* scr, int item, int lane) {
    const int g = item >> 8, cb = (item >> 4) & 15, nb = item & 15, c0 = cb * 8, n = nb * 64 + lane;
#pragma unroll
    for (int i = 0; i < 16; ++i) { const int idx = i * 64 + lane, c = idx >> 7, d = idx & 127; scr[d * 8 + c] = a.pool_mix[(size_t)(g * 128 + c0 + c) * 128 + d]; }
    LDS_WAIT(); asm volatile("" ::: "memory");
    float acc[8];
#pragma unroll
    for (int c = 0; c < 8; ++c) acc[c] = 0.f;
#pragma unroll 4
    for (int d = 0; d < 128; ++d) {
        const float wv = a.w_out[(size_t)(g * 128 + d) * D + n] * a.pool_scale[g * 128 + d];
        const f32x4 p0 = *(const LAS f32x4*)(scr + d * 8), p1 = *(const LAS f32x4*)(scr + d * 8 + 4);
        acc[0] += p0[0] * wv; acc[1] += p0[1] * wv; acc[2] += p0[2] * wv; acc[3] += p0[3] * wv;
        acc[4] += p1[0] * wv; acc[5] += p1[1] * wv; acc[6] += p1[2] * wv; acc[7] += p1[3] * wv;
    }
    u32x4 o; o.x = cvt_pk_bf16(acc[0], acc[1]); o.y = cvt_pk_bf16(acc[2], acc[3]); o.z = cvt_pk_bf16(acc[4], acc[5]); o.w = cvt_pk_bf16(acc[6], acc[7]);
    *(u32x4*)(W2T + (size_t)n * D + g * 128 + c0) = o;
    LDS_WAIT(); asm volatile("" ::: "memory");
}
__device__ __forceinline__ void p0_prologue(const Frame& F, const Args& a) {
    unsigned char* ws = a.ws;
    LAS float* scr = (LAS float*)(F.lds + F.wave * 16384);
    const int gw = F.vcu * 8 + F.wave, NGW = F.G * 8;
    bf16_t* WinT = (bf16_t*)(ws + WS_WIN); bf16_t* W2T = (bf16_t*)(ws + WS_W2); bf16_t* WgT = (bf16_t*)(ws + WS_WG); bf16_t* WpT = (bf16_t*)(ws + WS_WP);
    bf16_t* WguT = (bf16_t*)(ws + WS_WGU); bf16_t* WdnT = (bf16_t*)(ws + WS_WDN);
    constexpr int I_FOLD = 1024, I_IN = 16 * 64, I_OUT = 8 * 32, I_G = 16 * 32, I_P = 4 * 32, I_GU = NE * 16 * 64, I_DN = NE * 16 * 32;
    constexpr int NITEMS = I_FOLD + I_IN + I_OUT + I_G + I_P + I_GU + I_DN;
    for (int it = gw; it < NITEMS; it += NGW) {
        int r = it;
        if (r < I_FOLD) { fold_item(a, W2T, scr, r, F.lane); continue; } r -= I_FOLD;
        if (r < I_IN) { const int kb = r >> 6, nb = r & 63; tr_item(a.w_in + (size_t)(64 * kb) * DIN + 32 * nb, DIN, WinT + (size_t)(32 * nb) * D + 64 * kb, D, scr, F.lane); continue; } r -= I_IN;
        if (r < I_OUT) { const int kb = r >> 5, nb = r & 31; tr_item(a.w_out + (size_t)(DPOOL + 64 * kb) * D + 32 * nb, D, W2T + (size_t)(32 * nb) * D + DPOOL + 64 * kb, D, scr, F.lane); continue; } r -= I_OUT;
        if (r < I_G) { const int kb = r >> 5, nb = r & 31; tr_item(a.ple_gate_w + (size_t)(64 * kb) * D + 32 * nb, D, WgT + (size_t)(32 * nb) * D + 64 * kb, D, scr, F.lane); continue; } r -= I_G;
        if (r < I_P) { const int kb = r >> 5, nb = r & 31; tr_item(a.ple_proj + (size_t)(64 * kb) * D + 32 * nb, D, WpT + (size_t)(32 * nb) * PLE + 64 * kb, PLE, scr, F.lane); continue; } r -= I_P;
        if (r < I_GU) { const int e = r >> 10, q = r & 1023, kb = q >> 6, nb = q & 63, n0 = 32 * nb;
            const int h = n0 >> 10, j = n0 & 1023, drow = (j >> 7) * 256 + h * 128 + (j & 127);
            tr_item(a.w_gu + ((size_t)e * D + 64 * kb) * (2 * FF) + n0, 2 * FF, WguT + ((size_t)e * (2 * FF) + drow) * D + 64 * kb, D, scr, F.lane); continue; } r -= I_GU;
        { const int e = r >> 9, q = r & 511, kb = q >> 5, nb = q & 31;
            tr_item(a.w_dn + ((size_t)e * FF + 64 * kb) * D + 32 * nb, D, WdnT + ((size_t)e * D + 32 * nb) * FF + 64 * kb, FF, scr, F.lane); }
    }
    const size_t gt = (size_t)F.vcu * 512 + F.tid, NT = (size_t)F.G * 512;
    { const f32x4* s = (const f32x4*)a.x; u32x4* d = (u32x4*)(ws + WS_XB);
        for (size_t i = gt; i < (size_t)M * D / 8; i += NT) { const f32x4 v0 = s[2 * i], v1 = s[2 * i + 1]; u32x4 o; o.x = cvt_pk_bf16(v0[0], v0[1]); o.y = cvt_pk_bf16(v0[2], v0[3]); o.z = cvt_pk_bf16(v1[0], v1[1]); o.w = cvt_pk_bf16(v1[2], v1[3]); d[i] = o; } }
    { const f32x4* s = (const f32x4*)a.p; u32x4* d = (u32x4*)(ws + WS_PB);
        for (size_t i = gt; i < (size_t)M * PLE / 8; i += NT) { const f32x4 v0 = s[2 * i], v1 = s[2 * i + 1]; u32x4 o; o.x = cvt_pk_bf16(v0[0], v0[1]); o.y = cvt_pk_bf16(v0[2], v0[3]); o.z = cvt_pk_bf16(v1[0], v1[1]); o.w = cvt_pk_bf16(v1[2], v1[3]); d[i] = o; } }
}

__device__ __forceinline__ void unpack8(const u32x4 w, float (&f)[8]) { f[0] = bf_lo(w.x); f[1] = bf_hi(w.x); f[2] = bf_lo(w.y); f[3] = bf_hi(w.y); f[4] = bf_lo(w.z); f[5] = bf_hi(w.z); f[6] = bf_lo(w.w); f[7] = bf_hi(w.w); }
template <int W>
__device__ __forceinline__ void pool_item(const bf16_t* proj, bf16_t* A2, int t0, int g, int lane) {
    const int cb = lane & 15, ts = lane >> 4, tb = t0 + 16 * ts, c = g * 128 + cb * 8, seq0 = tb & ~(SEQ - 1);
    u32x4 rows[15 + W];
#pragma unroll
    for (int i = 0; i < 15 + W; ++i) { const int tr = tb - (W - 1) + i; const int trc = tr < seq0 ? seq0 : tr; rows[i] = *(const u32x4*)(proj + (size_t)trc * DIN + c); }
#pragma unroll
    for (int i = 0; i < W - 1; ++i) { const int tr = tb - (W - 1) + i; if (tr < seq0) rows[i] = (u32x4){0u, 0u, 0u, 0u}; }
    float S[8];
#pragma unroll
    for (int q = 0; q < 8; ++q) S[q] = 0.f;
#pragma unroll
    for (int i = 0; i < W - 1; ++i) { float f[8]; unpack8(rows[i], f);
#pragma unroll
        for (int q = 0; q < 8; ++q) S[q] += f[q]; }
#pragma unroll
    for (int j = 0; j < 16; ++j) { float cur[8], old[8]; unpack8(rows[j + W - 1], cur); unpack8(rows[j], old);
        const int sp1 = tb + j - seq0 + 1; const float inv = sp1 >= W ? (1.0f / (float)W) : (1.0f / (float)sp1); float o[8];
#pragma unroll
        for (int q = 0; q < 8; ++q) { S[q] += cur[q]; o[q] = S[q] * inv - cur[q]; S[q] -= old[q]; }
        u32x4 w; w.x = cvt_pk_bf16(o[0], o[1]); w.y = cvt_pk_bf16(o[2], o[3]); w.z = cvt_pk_bf16(o[4], o[5]); w.w = cvt_pk_bf16(o[6], o[7]);
        *(u32x4*)(A2 + (size_t)(tb + j) * D + c) = w; }
}
__device__ __forceinline__ void conv_item(const bf16_t* proj, bf16_t* A2, const float (&cw)[3][8], int tb, int lane) {
    const int c = 8 * lane, seq0 = tb & ~(SEQ - 1);
    u32x4 rc[10], rv[10], rb[8];
#pragma unroll
    for (int i = 0; i < 10; ++i) { const int tr = tb - 2 + i; const int trc = tr < seq0 ? seq0 : tr; const bf16_t* rp = proj + (size_t)trc * DIN + c; rc[i] = *(const u32x4*)(rp + 1024); rv[i] = *(const u32x4*)(rp + 1536); }
#pragma unroll
    for (int j = 0; j < 8; ++j) rb[j] = *(const u32x4*)(proj + (size_t)(tb + j) * DIN + 512 + c);
    float u[3][8];
#pragma unroll
    for (int i = 0; i < 2; ++i) { float fc[8], fv[8]; unpack8(rc[i], fc); unpack8(rv[i], fv); const bool ok = (tb - 2 + i) >= seq0;
#pragma unroll
        for (int q = 0; q < 8; ++q) u[i][q] = ok ? fc[q] * fv[q] : 0.f; }
#pragma unroll
    for (int j = 0; j < 8; ++j) { float fc[8], fv[8], fb[8], y[8]; unpack8(rc[j + 2], fc); unpack8(rv[j + 2], fv); unpack8(rb[j], fb);
#pragma unroll
        for (int q = 0; q < 8; ++q) { u[2][q] = fc[q] * fv[q]; y[q] = fb[q] * (cw[0][q] * u[0][q] + cw[1][q] * u[1][q] + cw[2][q] * u[2][q]); u[0][q] = u[1][q]; u[1][q] = u[2][q]; }
        u32x4 w; w.x = cvt_pk_bf16(y[0], y[1]); w.y = cvt_pk_bf16(y[2], y[3]); w.z = cvt_pk_bf16(y[4], y[5]); w.w = cvt_pk_bf16(y[6], y[7]);
        *(u32x4*)(A2 + (size_t)(tb + j) * D + DPOOL + c) = w; }
}
__device__ __forceinline__ void p2_mixer(const Frame& F, const Args& a) {
    const bf16_t* proj = (const bf16_t*)(a.ws + WS_PROJ); bf16_t* A2 = (bf16_t*)(a.ws + WS_A2);
    const int gw = F.vcu * 8 + F.wave, NGW = F.G * 8;
    for (int it = gw; it < 4 * (M / 64); it += NGW) { const int g = it & 3, t0 = (it >> 2) * 64;
        if (g == 0) pool_item<2>(proj, A2, t0, 0, F.lane); else if (g == 1) pool_item<4>(proj, A2, t0, 1, F.lane); else if (g == 2) pool_item<8>(proj, A2, t0, 2, F.lane); else pool_item<16>(proj, A2, t0, 3, F.lane); }
    float cw[3][8];
#pragma unroll
    for (int k = 0; k < 3; ++k)
#pragma unroll
        for (int i = 0; i < 8; ++i) cw[k][i] = a.conv_w[k * DPOOL + 8 * F.lane + i];
    for (int it = gw; it < M / 8; it += NGW) conv_item(proj, A2, cw, it * 8, F.lane);
}

__device__ __forceinline__ void load_row16(const float* rp, int lane, float (&v)[16]) {
#pragma unroll
    for (int j = 0; j < 2; ++j) { const f32x4 a0 = *(const f32x4*)(rp + 8 * lane + 512 * j), a1 = *(const f32x4*)(rp + 8 * lane + 512 * j + 4);
#pragma unroll
        for (int i = 0; i < 4; ++i) { v[8 * j + i] = a0[i]; v[8 * j + 4 + i] = a1[i]; } }
}
__device__ __forceinline__ void store_row16(float* rp, int lane, const float (&v)[16]) {
#pragma unroll
    for (int j = 0; j < 2; ++j) { *(f32x4*)(rp + 8 * lane + 512 * j) = (f32x4){v[8 * j], v[8 * j + 1], v[8 * j + 2], v[8 * j + 3]}; *(f32x4*)(rp + 8 * lane + 512 * j + 4) = (f32x4){v[8 * j + 4], v[8 * j + 5], v[8 * j + 6], v[8 * j + 7]}; }
}
__device__ __forceinline__ void unpack_row16(const u32x4 (&w)[2], float (&v)[16]) {
#pragma unroll
    for (int j = 0; j < 2; ++j) { v[8 * j] = bf_lo(w[j].x); v[8 * j + 1] = bf_hi(w[j].x); v[8 * j + 2] = bf_lo(w[j].y); v[8 * j + 3] = bf_hi(w[j].y); v[8 * j + 4] = bf_lo(w[j].z); v[8 * j + 5] = bf_hi(w[j].z); v[8 * j + 6] = bf_lo(w[j].w); v[8 * j + 7] = bf_hi(w[j].w); }
}
__device__ __forceinline__ void load_row16_bfw(const bf16_t* rp, int lane, u32x4 (&w)[2]) { w[0] = *(const u32x4*)(rp + 8 * lane); w[1] = *(const u32x4*)(rp + 8 * lane + 512); }
__device__ __forceinline__ void store_row16_bf(bf16_t* rp, int lane, const float (&v)[16]) {
#pragma unroll
    for (int j = 0; j < 2; ++j) { u32x4 o; o.x = cvt_pk_bf16(v[8 * j], v[8 * j + 1]); o.y = cvt_pk_bf16(v[8 * j + 2], v[8 * j + 3]); o.z = cvt_pk_bf16(v[8 * j + 4], v[8 * j + 5]); o.w = cvt_pk_bf16(v[8 * j + 6], v[8 * j + 7]); *(u32x4*)(rp + 8 * lane + 512 * j) = o; }
}
__device__ __forceinline__ void ln_row16(float (&v)[16], const float (&g)[16], const float (&b)[16]) {
    float s = 0.f;
#pragma unroll
    for (int i = 0; i < 16; ++i) s += v[i];
    const float mean = wave_sum(s) * (1.0f / D); float q = 0.f;
#pragma unroll
    for (int i = 0; i < 16; ++i) { v[i] -= mean; q += v[i] * v[i]; }
    const float rstd = 1.0f / sqrtf(wave_sum(q) * (1.0f / D) + LN_EPS);
#pragma unroll
    for (int i = 0; i < 16; ++i) v[i] = v[i] * rstd * g[i] + b[i];
}

__device__ __forceinline__ void ln_rows2(float (&v)[2][16], const float (&g)[16], const float (&b)[16]) {
    float s0 = 0.f, s1 = 0.f;
#pragma unroll
    for (int i = 0; i < 16; ++i) { s0 += v[0][i]; s1 += v[1][i]; }
#pragma unroll
    for (int o = 1; o < 64; o <<= 1) { s0 += __shfl_xor(s0, o); s1 += __shfl_xor(s1, o); }
    const float m0 = s0 * (1.0f / D), m1 = s1 * (1.0f / D); float q0 = 0.f, q1 = 0.f;
#pragma unroll
    for (int i = 0; i < 16; ++i) { v[0][i] -= m0; v[1][i] -= m1; q0 += v[0][i] * v[0][i]; q1 += v[1][i] * v[1][i]; }
#pragma unroll
    for (int o = 1; o < 64; o <<= 1) { q0 += __shfl_xor(q0, o); q1 += __shfl_xor(q1, o); }
    const float r0 = 1.0f / sqrtf(q0 * (1.0f / D) + LN_EPS), r1 = 1.0f / sqrtf(q1 * (1.0f / D) + LN_EPS);
#pragma unroll
    for (int i = 0; i < 16; ++i) { v[0][i] = v[0][i] * r0 * g[i] + b[i]; v[1][i] = v[1][i] * r1 * g[i] + b[i]; }
}
constexpr int XPITCH = 2064;
constexpr int L_XHI = 0, L_XLO = 16 * XPITCH, L_PART = 2 * 16 * XPITCH  ;
__device__ __forceinline__ void p4_ln1_router(const Frame& F, const Args& a) {
    bf16_t* X1B = (bf16_t*)(a.ws + WS_XB1); float* TG = (float*)(a.ws + WS_TG); int* LIST = (int*)(a.ws + WS_LIST);
    unsigned* gcnt = (unsigned*)(a.ws + WS_CTL) + CW_CNT;
    LAS unsigned* lhist = (LAS unsigned*)(F.lds + L_HIST); LAS unsigned* lbase = (LAS unsigned*)(F.lds + L_BASE); LAS unsigned* asg = (LAS unsigned*)(F.lds + L_ASG);
    const int lane = F.lane, w = F.wave, fr = lane & 15, fq = lane >> 4;
    if (F.tid < 32) lhist[F.tid] = 0u;
    float g[16], b[16];
    load_row16(a.ln1_g, lane, g); load_row16(a.ln1_b, lane, b);
    bf16x8 bhi[4][2], blo[4][2];
#pragma unroll
    for (int ks = 0; ks < 4; ++ks)
#pragma unroll
        for (int h = 0; h < 2; ++h) { unsigned hw[4], lw[4];
#pragma unroll
            for (int i2 = 0; i2 < 4; ++i2) { const int k = 128 * w + 32 * ks + 8 * fq + 2 * i2; const float v0 = a.router_w[(size_t)k * NE + 16 * h + fr], v1 = a.router_w[(size_t)(k + 1) * NE + 16 * h + fr];
                const unsigned hp = cvt_pk_bf16(v0, v1); const float r0 = v0 - bf_lo(hp), r1 = v1 - bf_hi(hp); hw[i2] = hp; lw[i2] = cvt_pk_bf16(r0, r1); }
            bhi[ks][h] = __builtin_bit_cast(bf16x8, (u32x4){hw[0], hw[1], hw[2], hw[3]}); blo[ks][h] = __builtin_bit_cast(bf16x8, (u32x4){lw[0], lw[1], lw[2], lw[3]}); }
    const float rbias = a.router_b[F.tid & 31];
    __syncthreads();
    int gl = 0;
    u32x4 vn[2][2];
#pragma unroll
    for (int rr = 0; rr < 2; ++rr) load_row16_bfw(X1B + (size_t)(F.vcu * 16 + 2 * w + rr) * D, lane, vn[rr]);
    for (int grp = F.vcu; grp < M / 16; grp += F.G, ++gl) {
        const int row0 = grp * 16;
        float v2[2][16];
#pragma unroll
        for (int rr = 0; rr < 2; ++rr) unpack_row16(vn[rr], v2[rr]);
        if (grp + F.G < M / 16) {
#pragma unroll
            for (int rr = 0; rr < 2; ++rr) load_row16_bfw(X1B + (size_t)((grp + F.G) * 16 + 2 * w + rr) * D, lane, vn[rr]); }
        ln_rows2(v2, g, b);
#pragma unroll
        for (int rr = 0; rr < 2; ++rr) { const int rl = 2 * w + rr; float (&v)[16] = v2[rr];
#pragma unroll
            for (int j = 0; j < 2; ++j) { unsigned hw[4], lw[4];
#pragma unroll
                for (int i2 = 0; i2 < 4; ++i2) { const float v0 = v[8 * j + 2 * i2], v1 = v[8 * j + 2 * i2 + 1]; const unsigned hp = cvt_pk_bf16(v0, v1); hw[i2] = hp; lw[i2] = cvt_pk_bf16(v0 - bf_lo(hp), v1 - bf_hi(hp)); }
                const u32x4 hv = {hw[0], hw[1], hw[2], hw[3]}, lv = {lw[0], lw[1], lw[2], lw[3]};
                *(u32x4*)(X1B + (size_t)(row0 + rl) * D + 8 * lane + 512 * j) = hv;
                *(LAS u32x4*)(F.lds + L_XHI + rl * XPITCH + (8 * lane + 512 * j) * 2) = hv; *(LAS u32x4*)(F.lds + L_XLO + rl * XPITCH + (8 * lane + 512 * j) * 2) = lv; } }
        __syncthreads();
        f32x4 acc[2] = {(f32x4){0.f, 0.f, 0.f, 0.f}, (f32x4){0.f, 0.f, 0.f, 0.f}};
#pragma unroll
        for (int ks = 0; ks < 4; ++ks) { const int ko = (128 * w + 32 * ks + 8 * fq) * 2;
            const bf16x8 ahi = *(const LAS bf16x8*)(F.lds + L_XHI + fr * XPITCH + ko), alo = *(const LAS bf16x8*)(F.lds + L_XLO + fr * XPITCH + ko);
#pragma unroll
            for (int h = 0; h < 2; ++h) { acc[h] = __builtin_amdgcn_mfma_f32_16x16x32_bf16(bhi[ks][h], ahi, acc[h], 0, 0, 0); acc[h] = __builtin_amdgcn_mfma_f32_16x16x32_bf16(blo[ks][h], ahi, acc[h], 0, 0, 0);
                acc[h] = __builtin_amdgcn_mfma_f32_16x16x32_bf16(bhi[ks][h], alo, acc[h], 0, 0, 0); } }
#pragma unroll
        for (int h = 0; h < 2; ++h) *(LAS f32x4*)(F.lds + L_PART + ((w * 16 + fr) * 32 + 16 * h + 4 * fq) * 4) = acc[h];
        __syncthreads();
        { const int rl = F.tid >> 5, e = F.tid & 31; float v = rbias;
#pragma unroll
            for (int ww = 0; ww < 8; ++ww) v += *(const LAS float*)(F.lds + L_PART + ((ww * 16 + rl) * 32 + e) * 4);
            bool taken = false; float sv[4]; int si[4];
#pragma unroll
            for (int r = 0; r < 4; ++r) { float bv = taken ? -__builtin_inff() : v; int bi = e;
#pragma unroll
                for (int mk = 1; mk < 32; mk <<= 1) { const float ov = __shfl_xor(bv, mk); const int oi = __shfl_xor(bi, mk); if (ov > bv || (ov == bv && oi < bi)) { bv = ov; bi = oi; } }
                sv[r] = bv; si[r] = bi; if (bi == e) taken = true; }
            const float p1 = __expf(sv[1] - sv[0]), p2 = __expf(sv[2] - sv[0]), p3 = __expf(sv[3] - sv[0]); const float inv = 1.0f / (1.0f + p1 + p2 + p3);
            if (e < 4) { const float gk = (e == 0 ? 1.0f : e == 1 ? p1 : e == 2 ? p2 : p3) * inv; const int ek = e == 0 ? si[0] : e == 1 ? si[1] : e == 2 ? si[2] : si[3];
                TG[(size_t)(row0 + rl) * 4 + e] = gk;
                const unsigned rank = atomicAdd((unsigned*)(lhist + ek), 1u);
                asg[(gl * 16 + rl) * 4 + e] = ((unsigned)ek << 16) | rank; } }
    }
    __syncthreads();
    if (F.tid < 32) lbase[F.tid] = __hip_atomic_fetch_add(gcnt + F.tid, lhist[F.tid], RLX_AGENT);
    __syncthreads();
    for (int s = F.tid; s < gl * 64; s += 512) { const unsigned av = asg[s]; const int e = av >> 16, rank = av & 0xffff; const int g2 = s >> 6, rl = (s >> 2) & 15, k = s & 3;
        const int tok = (F.vcu + g2 * F.G) * 16 + rl; LIST[(size_t)e * LCAP + lbase[e] + rank] = tok * 4 + k; }
}

__device__ __forceinline__ void moe_tables(const Frame& F, const Args& a, int ncol  ) {
    LAS int* tst = (LAS int*)(F.lds + L_TST); LAS int* lcnt = (LAS int*)(F.lds + L_CNT); LAS int* ut = (LAS int*)(F.lds + L_UT);
    unsigned* gcnt = (unsigned*)(a.ws + WS_CTL) + CW_CNT;
    if (F.tid < 32) lcnt[F.tid] = (int)__hip_atomic_load(gcnt + F.tid, RLX_AGENT);
    __syncthreads();
    if (F.tid == 0) { int s = 0; for (int e = 0; e < NE; ++e) { tst[e] = s; s += (lcnt[e] + 255) >> 8; } tst[NE] = s; }
    __syncthreads();
    if (F.tid < 32) { const int i = F.tid; const int T = tst[NE]; const long L = (long)i * F.G + F.vcu; int e = 0, tile = 0, pn = 0, valid = 0, lb = 0, nv = 0;
        if (L < (long)T * ncol) { tile = (int)(L / ncol); pn = (int)(L % ncol); valid = 1; for (int q = 0; q < NE; ++q) if (tst[q + 1] <= tile) e = q + 1;
            const int tin = tile - tst[e]; lb = e * LCAP + tin * 256; nv = lcnt[e] - tin * 256; nv = nv > 256 ? 256 : nv; }
        ut[i * 8 + 0] = e; ut[i * 8 + 1] = tile; ut[i * 8 + 2] = pn; ut[i * 8 + 3] = valid; ut[i * 8 + 4] = lb; ut[i * 8 + 5] = nv; ut[i * 8 + 6] = 0; ut[i * 8 + 7] = 0; }
    __syncthreads();
}

__device__ __forceinline__ void p7_combine_ln2(const Frame& F, const Args& a) {
    bf16_t* XB = (bf16_t*)(a.ws + WS_XB1); const float* TG = (const float*)(a.ws + WS_TG); const bf16_t* Y = (const bf16_t*)(a.ws + WS_Y);
    const int lane = F.lane, gw = F.vcu * 8 + F.wave, NGW = F.G * 8;
    float g[16], b[16]; load_row16(a.ln2_g, lane, g); load_row16(a.ln2_b, lane, b);
    for (int row = 2 * gw; row < M; row += 2 * NGW) { float v[2][16]; u32x4 xw[2][2], yw[2][4][2]; f32x4 gt[2];
#pragma unroll
        for (int r = 0; r < 2; ++r) { load_row16_bfw(XB + (size_t)(row + r) * D, lane, xw[r]); gt[r] = *(const f32x4*)(TG + (size_t)(row + r) * 4);
#pragma unroll
            for (int k = 0; k < 4; ++k)
#pragma unroll
                for (int j = 0; j < 2; ++j) yw[r][k][j] = *(const u32x4*)(Y + ((size_t)(row + r) * 4 + k) * D + 8 * lane + 512 * j); }
#pragma unroll
        for (int r = 0; r < 2; ++r) { unpack_row16(xw[r], v[r]);
#pragma unroll
            for (int i = 0; i < 16; ++i) v[r][i] *= ALPHA;
#pragma unroll
            for (int k = 0; k < 4; ++k)
#pragma unroll
                for (int j = 0; j < 2; ++j) { float f[8]; unpack8(yw[r][k][j], f);
#pragma unroll
                    for (int i = 0; i < 8; ++i) v[r][8 * j + i] += gt[r][k] * f[i]; } }
        ln_rows2(v, g, b);
#pragma unroll
        for (int r = 0; r < 2; ++r) store_row16_bf(XB + (size_t)(row + r) * D, lane, v[r]); }
}
__device__ __forceinline__ void p9_ln3(const Frame& F, const Args& a) {
    float* R = a.out; const bf16_t* H3 = (const bf16_t*)(a.ws + WS_H3); const int lane = F.lane, gw = F.vcu * 8 + F.wave, NGW = F.G * 8;
    float g[16], b[16]; load_row16(a.ln3_g, lane, g); load_row16(a.ln3_b, lane, b);
    for (int row = 2 * gw; row < M; row += 2 * NGW) { float v[2][16]; u32x4 hw[2][2];
        load_row16_bfw(H3 + (size_t)row * D, lane, hw[0]); load_row16_bfw(H3 + (size_t)(row + 1) * D, lane, hw[1]);
        unpack_row16(hw[0], v[0]); unpack_row16(hw[1], v[1]);
        ln_rows2(v, g, b);
        store_row16(R + (size_t)row * D, lane, v[0]); store_row16(R + (size_t)(row + 1) * D, lane, v[1]); }
}

__global__ void __launch_bounds__(512, 2) fwd_kernel(Args args) {
    extern __shared__ __attribute__((aligned(16))) unsigned char lds_raw[];
    Frame F;
    F.lds = (LAS unsigned char*)lds_raw;
    F.tid = threadIdx.x; F.lane = F.tid & 63; F.wave = __builtin_amdgcn_readfirstlane(F.tid >> 6);
    F.G = gridDim.x; { const int bx = blockIdx.x; F.vcu = (F.G % 8 == 0) ? (bx % 8) * (F.G / 8) + bx / 8 : bx; }
    unsigned char* ws = args.ws;
    volatile LAS unsigned* MISC = (volatile LAS unsigned*)(F.lds + L_MISC);
    for (int u = F.tid; u < (LDS_BYTES - RING_BYTES) / 4; u += 512) ((LAS unsigned*)(F.lds + RING_BYTES))[u] = 0u;
    __syncthreads();
    XcdBarrier bar; bar.bar = (unsigned*)(ws + WS_CTL) + CW_BAR; bar.x = 0; bar.st = nullptr;
    if (MK_N_LAUNCHES == 1) bar = xcd_barrier_post((unsigned*)(ws + WS_CTL) + CW_BAR, MISC + 8);
    const int lo = args.ph_lo, hi = args.ph_hi;
#ifndef PHASE_MASK
#define PHASE_MASK 0x3ff
#endif
#define IN(k) (((PHASE_MASK >> (k)) & 1) && lo <= (k) && (k) < hi)
#define GRID_BAR(k) do { if (IN(k) && IN((k) + 1)) xcd_barrier(bar); } while (0)

    if (IN(0)) { _Pragma("unroll") for (int rep = 0; rep < REP0; ++rep) p0_prologue(F, args); GRID_BAR(0); }

    if (IN(1)) {
        _Pragma("unroll") for (int rep = 0; rep < REP1; ++rep) {
        { pg8::DenseOrder S; S.init(ws + WS_XB, ws + WS_WIN, M, DIN, D, F.G, (int)blockIdx.x); pg8::EpiBf16 E{(bf16_t*)(ws + WS_PROJ), DIN};
          pg8::gemm_phase<pg8::EpiBf16, pg8::DenseOrder>(F.lds, D, S, E); }
        { pg8::DenseOrder S; S.init(ws + WS_PB, ws + WS_WP, M, D, PLE, F.G, (int)blockIdx.x); pg8::EpiBf16 E{(bf16_t*)(ws + WS_PLE), D};
          pg8::gemm_phase<pg8::EpiBf16, pg8::DenseOrder>(F.lds, PLE, S, E); }
        }
        GRID_BAR(1);
    }

    if (IN(2)) { _Pragma("unroll") for (int rep = 0; rep < REP2; ++rep) p2_mixer(F, args); GRID_BAR(2); }

    if (IN(3)) {
        pg8::DenseOrder S; S.init(ws + WS_A2, ws + WS_W2, M, D, D, F.G, (int)blockIdx.x); pg8::EpiH1 E{(const bf16_t*)(ws + WS_XB), (bf16_t*)(ws + WS_XB1)};
        _Pragma("unroll") for (int rep = 0; rep < REP3; ++rep) pg8::gemm_phase<pg8::EpiH1, pg8::DenseOrder>(F.lds, D, S, E);
        GRID_BAR(3);
    }

    if (IN(4)) { p4_ln1_router(F, args); GRID_BAR(4); }

    if (IN(5)) {
        moe_tables(F, args, 8);
        pg8::MoeGuOrder S; S.ut = (const LAS int*)(F.lds + L_UT); S.A = (const char*)(ws + WS_XB1); S.Bt = (const char*)(ws + WS_WGU); S.list = (const int*)(ws + WS_LIST); S.K = D; S.bstride_e = (size_t)2 * FF * D * 2; S.gather = true;
        pg8::EpiGU E{(bf16_t*)(ws + WS_HID), args.b_gu};
        _Pragma("unroll") for (int rep = 0; rep < REP5; ++rep) pg8::gemm_phase<pg8::EpiGU, pg8::MoeGuOrder>(F.lds, D, S, E);
        GRID_BAR(5);
    }

    if (IN(6)) {
        moe_tables(F, args, 4);
        pg8::MoeDnOrder S; S.ut = (const LAS int*)(F.lds + L_UT); S.A = (const char*)(ws + WS_HID); S.Bt = (const char*)(ws + WS_WDN); S.list = (const int*)(ws + WS_LIST); S.K = FF; S.bstride_e = (size_t)D * FF * 2; S.gather = false;
        pg8::EpiDown E{(bf16_t*)(ws + WS_Y), args.b_dn, (const int*)(ws + WS_LIST)};
        _Pragma("unroll") for (int rep = 0; rep < REP6; ++rep) pg8::gemm_phase<pg8::EpiDown, pg8::MoeDnOrder>(F.lds, FF, S, E);
        GRID_BAR(6);
    }

    if (IN(7)) { p7_combine_ln2(F, args); GRID_BAR(7); }

    if (IN(8)) {
        pg8::DenseOrder S; S.init(ws + WS_XB1, ws + WS_WG, M, D, D, F.G, (int)blockIdx.x); pg8::EpiGate E{(const bf16_t*)(ws + WS_XB1), (const bf16_t*)(ws + WS_PLE), args.ple_gate_b, (bf16_t*)(ws + WS_H3)};
        pg8::gemm_phase<pg8::EpiGate, pg8::DenseOrder>(F.lds, D, S, E);
        GRID_BAR(8);
    }

    if (IN(9)) { p9_ln3(F, args); }
#undef IN
#undef GRID_BAR
}

extern "C" void kernel_launch(void* const* d_in, const int* in_sizes, int n_in, void* d_out, int out_size, void* d_ws, size_t ws_size, hipStream_t stream) {
    static int grid = 0;
    if (grid == 0) {
        if (n_in != 22 || in_sizes[0] != M * D || out_size != M * D || ws_size < WS_END) { fprintf(stderr, "kernel_launch: unexpected shapes (n_in %d, in0 %d, out %d, ws %zu); nothing launched\n", n_in, n_in > 0 ? in_sizes[0] : -1, out_size, ws_size); grid = -1; return; }
        int dev = 0, cus = 0, per_cu = 0;
        if (hipGetDevice(&dev) != hipSuccess || hipDeviceGetAttribute(&cus, hipDeviceAttributeMultiprocessorCount, dev) != hipSuccess) { grid = -1; return; }
        if (hipFuncSetAttribute((const void*)fwd_kernel, hipFuncAttributeMaxDynamicSharedMemorySize, LDS_BYTES) != hipSuccess) { fprintf(stderr, "kernel_launch: hipFuncSetAttribute failed\n"); grid = -1; return; }
        if (hipOccupancyMaxActiveBlocksPerMultiprocessor(&per_cu, (const void*)fwd_kernel, 512, LDS_BYTES) != hipSuccess || per_cu < 1) fprintf(stderr, "kernel_launch: occupancy query reports %d\n", per_cu);
        (void)hipGetLastError();
        grid = cus;
        if (grid != 256) fprintf(stderr, "kernel_launch: %d CUs (expected 256)\n", grid);
    }
    if (grid < 0) return;
    (void)hipMemsetAsync((char*)d_ws + WS_CTL, 0, CTL_ZERO_BYTES, stream);
    Args a{};
    const float** ap = (const float**)&a;
    for (int i = 0; i < 22; ++i) ap[i] = (const float*)d_in[i];
    a.out = (float*)d_out; a.ws = (unsigned char*)d_ws;
#if MK_N_LAUNCHES == 1
    a.ph_lo = 0; a.ph_hi = NPHASE;
    hipLaunchKernelGGL(fwd_kernel, dim3(grid), dim3(512), LDS_BYTES, stream, a);
#else
    for (int ph = 0; ph < NPHASE; ++ph) { a.ph_lo = ph; a.ph_hi = ph + 1; hipLaunchKernelGGL(fwd_kernel, dim3(grid), dim3(512), LDS_BYTES, stream, a); }
#endif
}
```

```cpp
#include <hip/hip_runtime.h>
#include <cstdio>
#include <cstdint>

#ifndef MK_N_LAUNCHES
#define MK_N_LAUNCHES 1
#endif

#ifndef REP0
#define REP0 1
#endif
#ifndef REP1
#define REP1 1
#endif
#ifndef REP2
#define REP2 1
#endif
#ifndef REP3
#define REP3 1
#endif
#ifndef REP5
#define REP5 1
#endif
#ifndef REP6
#define REP6 1
#endif
#define LAS __attribute__((address_space(3)))
#define GAS __attribute__((address_space(1)))
typedef unsigned short bf16_t;
typedef short bf16x8 __attribute__((ext_vector_type(8)));
typedef float f32x4 __attribute__((ext_vector_type(4)));
typedef float f32x2 __attribute__((ext_vector_type(2)));
typedef unsigned u32x4 __attribute__((ext_vector_type(4)));
typedef unsigned u32x2 __attribute__((ext_vector_type(2)));
typedef int i32x4 __attribute__((ext_vector_type(4)));
typedef int i32x8 __attribute__((ext_vector_type(8)));
typedef GAS unsigned gu32;

constexpr int M = 32768, D = 1024, SEQ = 4096, DIN = 2048, NE = 32, TOPK = 4, FF = 1024, PLE = 256, DPOOL = 512;
constexpr int NA = M * TOPK;
constexpr int LCAP = M;
constexpr int MAXTILES = NA / 256 + NE;
constexpr float ALPHA = 1.189207115002721f;
constexpr float LN_EPS = 1e-5f;
constexpr float SW_LIMIT = 7.0f, SW_ALPHA = 1.702f;
constexpr int NPHASE = 10;
constexpr float WGU_MUL = 32.0f, WDN_MUL = 64.0f, HID_MUL = 4.0f;
constexpr int SCL_WGU = 0x7a7a7a7a  , SCL_WDN = 0x79797979  , SCL_HID = 0x7d7d7d7d  ;

constexpr size_t MiB = 1u << 20;
constexpr size_t WS_CTL = 0, CTL_ZERO_BYTES = 1 * MiB;
constexpr size_t WS_WIN = 1 * MiB;
constexpr size_t WS_W2 = 5 * MiB;
constexpr size_t WS_WG = 7 * MiB;
constexpr size_t WS_WP = 9 * MiB;
constexpr size_t WS_TG = 10 * MiB;
constexpr size_t WS_LIST = 11 * MiB;
constexpr size_t WS_WGU = 16 * MiB;
constexpr size_t WS_WDN = 144 * MiB;
constexpr size_t WS_XB1 = 208 * MiB;
constexpr size_t WS_PLE = 272 * MiB;
constexpr size_t WS_HID = 336 * MiB;
constexpr size_t WS_PROJ = 336 * MiB;
constexpr size_t WS_A2 = 464 * MiB;
constexpr size_t WS_XB = 528 * MiB;
constexpr size_t WS_PB = 592 * MiB;
constexpr size_t WS_H3 = 336 * MiB;
constexpr size_t WS_Y = 608 * MiB;
constexpr size_t WS_X1F8 = 864 * MiB;
constexpr size_t WS_END = 896 * MiB;
static_assert(WS_HID + (size_t)MAXTILES * 256 * 1024 * 2 <= WS_Y, "hidden fits");
constexpr int CW_TMO = 0, CW_CODE = 1, CW_CNT = 64  , CW_BAR = 4096;

constexpr int RING_BYTES = 131072;
constexpr int L_MISC = RING_BYTES;
constexpr int L_TST = RING_BYTES + 128;
constexpr int L_CNT = RING_BYTES + 272;
constexpr int L_UT = RING_BYTES + 640;
constexpr int L_HIST = RING_BYTES + 1664;
constexpr int L_BASE = RING_BYTES + 1792;
constexpr int L_ASG = RING_BYTES + 2048;
constexpr int LDS_BYTES = 147456;
static_assert(L_ASG + 2048 <= LDS_BYTES, "LDS map");

#define RLX_AGENT __ATOMIC_RELAXED, __HIP_MEMORY_SCOPE_AGENT
#define LDS_WAIT() asm volatile("s_waitcnt lgkmcnt(0)" ::: "memory")
#define VM_WAIT() asm volatile("s_waitcnt vmcnt(0)" ::: "memory")

__device__ __forceinline__ unsigned cvt_pk_bf16(float lo, float hi) { unsigned r; asm volatile("v_cvt_pk_bf16_f32 %0, %1, %2" : "=v"(r) : "v"(lo), "v"(hi)); return r; }
__device__ __forceinline__ unsigned cvt4_fp8(float a, float b, float c, float d) {
    a = __builtin_fminf(__builtin_fmaxf(a, -448.f), 448.f); b = __builtin_fminf(__builtin_fmaxf(b, -448.f), 448.f); c = __builtin_fminf(__builtin_fmaxf(c, -448.f), 448.f); d = __builtin_fminf(__builtin_fmaxf(d, -448.f), 448.f);
    int w = 0; w = __builtin_amdgcn_cvt_pk_fp8_f32(a, b, w, false); w = __builtin_amdgcn_cvt_pk_fp8_f32(c, d, w, true); return (unsigned)w; }
__device__ __forceinline__ float bf_lo(unsigned w) { return __uint_as_float(w << 16); }
__device__ __forceinline__ float bf_hi(unsigned w) { return __uint_as_float(w & 0xffff0000u); }
__device__ __forceinline__ float wave_sum(float v) {
#pragma unroll
    for (int o = 1; o < 64; o <<= 1) v += __shfl_xor(v, o);
    return v;
}

namespace pg8 {
constexpr int BM = 256, BK = 64, HALF = 128, HTB = HALF * BK * 2, STAGE_BYTES = 8 * HTB, NXCD = 8, WGM = 8;
__host__ __device__ __forceinline__ int lds_byte(int r, int c) { const int st = (r >> 4) * 2 + (c >> 5), rr = r & 15, cc = c & 31, ob = rr * 64 + cc * 2; return st * 1024 + (ob ^ (((ob >> 9) & 1) << 5)); }
__host__ __device__ __forceinline__ void stage_rc(int b, int& R, int& C) { const int st = b / 1024, sb = b % 1024, swz = sb ^ (((sb >> 9) & 1) << 5); R = (st >> 1) * 16 + swz / 64; C = (st & 1) * 32 + (swz % 64) / 2; }
__host__ __device__ __forceinline__ int perm32(int rho) { const int n = rho >> 4, i = rho & 15; return 8 * (i >> 2) + 4 * n + (i & 3); }

struct Unit { const char* A; const char* B; int pm, pn, e, lbase, nvalid; };

struct DenseOrder {
    static constexpr bool GATHER = false;
    const char* A; const char* Bt; int KB, nM, nN, nwg, G, c;
    __device__ __forceinline__ void init(const void* A_, const void* Bt_, int M_, int N_, int KB_, int G_, int c_) { A = (const char*)A_; Bt = (const char*)Bt_; KB = KB_; nM = M_ / BM; nN = N_ / BM; nwg = nM * nN; G = G_; c = c_; }
    __device__ __forceinline__ bool next(int i, Unit& u) const {
        const long L = (long)i * G + c; if (L >= nwg) return false;
        int wgid = (int)L; { const int q = nwg / NXCD, r = nwg % NXCD, xcd = wgid % NXCD, off = wgid / NXCD; wgid = (xcd < r ? xcd * (q + 1) : r * (q + 1) + (xcd - r) * q) + off; }
        const int nig = WGM * nN, gid = wgid / nig, fm = gid * WGM, gsz = (nM - fm) < WGM ? (nM - fm) : WGM;
        u.pm = fm + ((wgid % nig) % gsz); u.pn = (wgid % nig) / gsz;
        u.A = A + (size_t)u.pm * BM * KB; u.B = Bt + (size_t)u.pn * BM * KB; u.e = 0; u.lbase = 0; u.nvalid = BM; return true;
    }
    __device__ __forceinline__ void rows(const Unit&, int R0, unsigned (&off)[4]) const {
#pragma unroll
        for (int j = 0; j < 4; ++j) off[j] = (unsigned)((R0 + 64 * j) * KB);
    }
};

struct MoeOrder {
    const LAS int* ut; const char* A; const char* Bt; const int* list; int KB; size_t bstride_e; bool gather;
    __device__ __forceinline__ bool next_(int i, Unit& u) const {
        if (i >= 32) return false;
        const LAS int* t = ut + i * 8;
        const int e = __builtin_amdgcn_readfirstlane(t[0]), tile = __builtin_amdgcn_readfirstlane(t[1]), pn = __builtin_amdgcn_readfirstlane(t[2]), valid = __builtin_amdgcn_readfirstlane(t[3]);
        const int lb = __builtin_amdgcn_readfirstlane(t[4]), nv = __builtin_amdgcn_readfirstlane(t[5]);
        if (!valid) return false;
        u.e = e; u.pm = tile; u.pn = pn; u.lbase = lb; u.nvalid = nv;
        u.B = Bt + (size_t)e * bstride_e + (size_t)pn * BM * KB;
        u.A = gather ? A : A + (size_t)tile * BM * KB;
        return true;
    }
};
struct MoeGuOrder : MoeOrder {
    static constexpr bool GATHER = true;
    __device__ __forceinline__ bool next(int i, Unit& u) const { return next_(i, u); }
    __device__ __forceinline__ void rows(const Unit& u, int R0, unsigned (&off)[4]) const {
#pragma unroll
        for (int j = 0; j < 4; ++j) { const int r = R0 + 64 * j; int aid = 0; if (r < u.nvalid) aid = list[u.lbase + r]; off[j] = (unsigned)(aid >> 2) * (unsigned)KB; }
    }
};
struct MoeDnOrder : MoeOrder {
    static constexpr bool GATHER = false;
    __device__ __forceinline__ bool next(int i, Unit& u) const { return next_(i, u); }
    __device__ __forceinline__ void rows(const Unit&, int R0, unsigned (&off)[4]) const {
#pragma unroll
        for (int j = 0; j < 4; ++j) off[j] = (unsigned)((R0 + 64 * j) * KB);
    }
};

struct EpiBf16 {
    static constexpr bool PERM = true;
    bf16_t* O; int ldc;
    __device__ __forceinline__ void operator()(const f32x4 (&acc)[2][2][4][2], const Unit& u, int wr, int wc, int fr, int fq) const {
        const int row0 = u.pm * BM + wr * 64 + fr, col0 = u.pn * BM + wc * 32 + 8 * fq;
#pragma unroll
        for (int ai = 0; ai < 2; ++ai)
#pragma unroll
            for (int m = 0; m < 4; ++m) { bf16_t* rowp = O + (size_t)(row0 + ai * HALF + m * 16) * ldc + col0;
#pragma unroll
                for (int bj = 0; bj < 2; ++bj) { const f32x4 v0 = acc[ai][bj][m][0], v1 = acc[ai][bj][m][1];
                    u32x4 w; w.x = cvt_pk_bf16(v0[0], v0[1]); w.y = cvt_pk_bf16(v0[2], v0[3]); w.z = cvt_pk_bf16(v1[0], v1[1]); w.w = cvt_pk_bf16(v1[2], v1[3]);
                    *(u32x4*)(rowp + bj * HALF) = w; } }
    }
};
struct EpiH1 {
    static constexpr bool PERM = true;
    const bf16_t* xb; bf16_t* H1;
    __device__ __forceinline__ void operator()(const f32x4 (&acc)[2][2][4][2], const Unit& u, int wr, int wc, int fr, int fq) const {
        const int row0 = u.pm * BM + wr * 64 + fr, col0 = u.pn * BM + wc * 32 + 8 * fq;
#pragma unroll
        for (int ai = 0; ai < 2; ++ai)
#pragma unroll
            for (int m = 0; m < 4; ++m) { const size_t off = (size_t)(row0 + ai * HALF + m * 16) * D + col0;
#pragma unroll
                for (int bj = 0; bj < 2; ++bj) { const u32x4 xw = *(const u32x4*)(xb + off + bj * HALF); const f32x4 v0 = acc[ai][bj][m][0], v1 = acc[ai][bj][m][1];
                    u32x4 w; w.x = cvt_pk_bf16(bf_lo(xw.x) * ALPHA + v0[0], bf_hi(xw.x) * ALPHA + v0[1]); w.y = cvt_pk_bf16(bf_lo(xw.y) * ALPHA + v0[2], bf_hi(xw.y) * ALPHA + v0[3]);
                    w.z = cvt_pk_bf16(bf_lo(xw.z) * ALPHA + v1[0], bf_hi(xw.z) * ALPHA + v1[1]); w.w = cvt_pk_bf16(bf_lo(xw.w) * ALPHA + v1[2], bf_hi(xw.w) * ALPHA + v1[3]);
                    *(u32x4*)(H1 + off + bj * HALF) = w; }
                asm volatile("" ::: "memory"); }
    }
};
struct EpiGU {
    static constexpr bool PERM = true;
    unsigned char* H; const float* bgu;
    __device__ __forceinline__ void operator()(const f32x4 (&acc)[2][2][4][2], const Unit& u, int wr, int wc, int fr, int fq) const {
        const int row0 = u.pm * BM + wr * 64 + fr, cc = u.pn * HALF + wc * 32 + 8 * fq;
        const float* bp = bgu + (size_t)u.e * (2 * FF) + cc;
        f32x4 bg[2], bu[2];
#pragma unroll
        for (int n = 0; n < 2; ++n) { bg[n] = *(const f32x4*)(bp + 4 * n); bu[n] = *(const f32x4*)(bp + FF + 4 * n); }
#pragma unroll
        for (int ai = 0; ai < 2; ++ai)
#pragma unroll
            for (int m = 0; m < 4; ++m) { unsigned char* rowp = H + (size_t)(row0 + ai * HALF + m * 16) * FF + cc; float h[8];
#pragma unroll
                for (int n = 0; n < 2; ++n)
#pragma unroll
                    for (int i = 0; i < 4; ++i) {
                        const float g = fminf(acc[ai][0][m][n][i] + bg[n][i], SW_LIMIT);
                        const float up = fminf(fmaxf(acc[ai][1][m][n][i] + bu[n][i], -SW_LIMIT), SW_LIMIT);
                        const float sg = __builtin_amdgcn_rcpf(1.0f + __builtin_amdgcn_exp2f(g * (-SW_ALPHA * 1.4426950408889634f)));
                        h[4 * n + i] = (up + 1.0f) * (g * sg) * HID_MUL; }
                u32x2 w; w.x = cvt4_fp8(h[0], h[1], h[2], h[3]); w.y = cvt4_fp8(h[4], h[5], h[6], h[7]);
                *(u32x2*)rowp = w; }
    }
};
struct EpiDown {
    static constexpr bool PERM = true;
    bf16_t* Y; const float* bdn; const int* list;
    __device__ __forceinline__ void operator()(const f32x4 (&acc)[2][2][4][2], const Unit& u, int wr, int wc, int fr, int fq) const {
        const int col0 = u.pn * BM + wc * 32 + 8 * fq;
        const float* bp = bdn + (size_t)u.e * D + col0;
        f32x4 bv[2][2];
#pragma unroll
        for (int bj = 0; bj < 2; ++bj)
#pragma unroll
            for (int n = 0; n < 2; ++n) bv[bj][n] = *(const f32x4*)(bp + bj * HALF + 4 * n);
#pragma unroll
        for (int ai = 0; ai < 2; ++ai)
#pragma unroll
            for (int m = 0; m < 4; ++m) { const int r = ai * HALF + wr * 64 + m * 16 + fr;
                if (r < u.nvalid) { const int aid = list[u.lbase + r]; bf16_t* rowp = Y + (size_t)aid * D + col0;
#pragma unroll
                    for (int bj = 0; bj < 2; ++bj) { const f32x4 v0 = acc[ai][bj][m][0] + bv[bj][0], v1 = acc[ai][bj][m][1] + bv[bj][1];
                        u32x4 w; w.x = cvt_pk_bf16(v0[0], v0[1]); w.y = cvt_pk_bf16(v0[2], v0[3]); w.z = cvt_pk_bf16(v1[0], v1[1]); w.w = cvt_pk_bf16(v1[2], v1[3]);
                        *(u32x4*)(rowp + bj * HALF) = w; } } }
    }
};
struct EpiGate {
    static constexpr bool PERM = true;
    const bf16_t* x2b; const bf16_t* ple; const float* bg; bf16_t* H3;
    __device__ __forceinline__ void operator()(const f32x4 (&acc)[2][2][4][2], const Unit& u, int wr, int wc, int fr, int fq) const {
        const int row0 = u.pm * BM + wr * 64 + fr, col0 = u.pn * BM + wc * 32 + 8 * fq;
        f32x4 bv[2][2];
#pragma unroll
        for (int bj = 0; bj < 2; ++bj)
#pragma unroll
            for (int n = 0; n < 2; ++n) bv[bj][n] = *(const f32x4*)(bg + col0 + bj * HALF + 4 * n);
#pragma unroll
        for (int ai = 0; ai < 2; ++ai)
#pragma unroll
            for (int m = 0; m < 4; ++m) { const size_t off = (size_t)(row0 + ai * HALF + m * 16) * D + col0;
#pragma unroll
                for (int bj = 0; bj < 2; ++bj) { const u32x4 xw = *(const u32x4*)(x2b + off + bj * HALF), pw = *(const u32x4*)(ple + off + bj * HALF);
                    const float xs[8] = {bf_lo(xw.x), bf_hi(xw.x), bf_lo(xw.y), bf_hi(xw.y), bf_lo(xw.z), bf_hi(xw.z), bf_lo(xw.w), bf_hi(xw.w)};
                    const float ps[8] = {bf_lo(pw.x), bf_hi(pw.x), bf_lo(pw.y), bf_hi(pw.y), bf_lo(pw.z), bf_hi(pw.z), bf_lo(pw.w), bf_hi(pw.w)};
                    float r[8];
#pragma unroll
                    for (int n = 0; n < 2; ++n)
#pragma unroll
                        for (int i = 0; i < 4; ++i) { const float z = acc[ai][bj][m][n][i] + bv[bj][n][i]; const float sg = __builtin_amdgcn_rcpf(1.0f + __builtin_amdgcn_exp2f(z * -1.4426950408889634f)); r[4 * n + i] = xs[4 * n + i] * ALPHA + sg * ps[4 * n + i]; }
                    u32x4 w; w.x = cvt_pk_bf16(r[0], r[1]); w.y = cvt_pk_bf16(r[2], r[3]); w.z = cvt_pk_bf16(r[4], r[5]); w.w = cvt_pk_bf16(r[6], r[7]);
                    *(u32x4*)(H3 + off + bj * HALF) = w; }
                asm volatile("" ::: "memory"); }
    }
};

template <class Epi, class Sched, bool FP8 = false>
__device__ __forceinline__ void gemm_phase(LAS unsigned char* lds, const int KB, const Sched& S, const Epi& E, const int scl_w = 0x7f7f7f7f, const int scl_x = 0x7f7f7f7f) {
    const int tid = threadIdx.x, wid = __builtin_amdgcn_readfirstlane(tid >> 6), lane = tid & 63, wr = wid >> 2, wc = wid & 3, fr = lane & 15, fq = lane >> 4;
    const int nt = KB / 128;
    int R0, C0; stage_rc(tid * 16, R0, C0);
    unsigned voffB[2];
#pragma unroll
    for (int i = 0; i < 2; ++i) { const int R = R0 + 64 * i; const int Rb = Epi::PERM ? ((R & ~31) + perm32(R & 31)) : R; voffB[i] = (unsigned)(Rb * KB + C0 * 2); }
    const unsigned coff = (unsigned)C0 * 2u;
    const size_t kstep = (size_t)(BK * 2);
    const size_t hstep = (size_t)HALF * KB;
    const unsigned ldsw = (unsigned)wid * 1024u;
    const int aoff = lds_byte(wr * 64 + fr, fq * 8), boff = lds_byte(wc * 32 + fr, fq * 8);
#define PG8_SA(b, h) (((b) * 2 + (h)) * HTB)
#define PG8_SB(b, h) ((4 + (b) * 2 + (h)) * HTB)
#define PG8_STAGE_B(bufoff, gbase) do { _Pragma("unroll") for (int _i = 0; _i < 2; ++_i) \
        __builtin_amdgcn_global_load_lds((const unsigned*)((const char*)(gbase) + voffB[_i]), (LAS unsigned*)(lds + (bufoff) + ldsw + _i * 8192), 16, 0, 0); } while (0)
#define PG8_STAGE_A(bufoff, gbase, off, h) do { _Pragma("unroll") for (int _i = 0; _i < 2; ++_i) \
        __builtin_amdgcn_global_load_lds((const unsigned*)((const char*)(gbase) + (off)[2 * (h) + _i]), (LAS unsigned*)(lds + (bufoff) + ldsw + _i * 8192), 16, 0, 0); } while (0)
#define PG8_LDA(dst, b, h) do { _Pragma("unroll") for (int m = 0; m < 4; ++m) { const i32x4 _l = *(const LAS i32x4*)(lds + PG8_SA(b, h) + aoff + m * 2048), _h = *(const LAS i32x4*)(lds + PG8_SA(b, h) + aoff + m * 2048 + 1024); \
        dst[m] = __builtin_shufflevector(_l, _h, 0, 1, 2, 3, 4, 5, 6, 7); } } while (0)
#define PG8_LDB(dst, b, h) do { _Pragma("unroll") for (int n = 0; n < 2; ++n) { const i32x4 _l = *(const LAS i32x4*)(lds + PG8_SB(b, h) + boff + n * 2048), _h = *(const LAS i32x4*)(lds + PG8_SB(b, h) + boff + n * 2048 + 1024); \
        dst[n] = __builtin_shufflevector(_l, _h, 0, 1, 2, 3, 4, 5, 6, 7); } } while (0)
#define PG8_MMA(ai, bj, At, Bt) do { __builtin_amdgcn_s_setprio(1); _Pragma("unroll") for (int m = 0; m < 4; ++m) _Pragma("unroll") for (int n = 0; n < 2; ++n) { \
        if constexpr (FP8) { asm volatile("v_mfma_scale_f32_16x16x128_f8f6f4 %0, %1, %2, %0, %3, %4 op_sel_hi:[0,0,0]" : "+v"(acc[ai][bj][m][n]) : "v"(Bt[n]), "v"(At[m]), "v"(scl_w), "v"(scl_x)); } \
        else { acc[ai][bj][m][n] = __builtin_amdgcn_mfma_f32_16x16x32_bf16(__builtin_bit_cast(bf16x8, __builtin_shufflevector(Bt[n], Bt[n], 0, 1, 2, 3)), __builtin_bit_cast(bf16x8, __builtin_shufflevector(At[m], At[m], 0, 1, 2, 3)), acc[ai][bj][m][n], 0, 0, 0); \
               acc[ai][bj][m][n] = __builtin_amdgcn_mfma_f32_16x16x32_bf16(__builtin_bit_cast(bf16x8, __builtin_shufflevector(Bt[n], Bt[n], 4, 5, 6, 7)), __builtin_bit_cast(bf16x8, __builtin_shufflevector(At[m], At[m], 4, 5, 6, 7)), acc[ai][bj][m][n], 0, 0, 0); } } __builtin_amdgcn_s_setprio(0); } while (0)
#define PG8_WAIT_V(n) asm volatile("s_waitcnt vmcnt(" #n ")" ::: "memory")
#define PG8_WAIT_L(n) asm volatile("s_waitcnt lgkmcnt(" #n ")" ::: "memory")
#define PG8_BAR __builtin_amdgcn_s_barrier()
#define PG8_SCHED __builtin_amdgcn_sched_barrier(0)
#define PG8_PIN4(o) asm volatile("" : "+v"((o)[0]), "+v"((o)[1]), "+v"((o)[2]), "+v"((o)[3]))
    Unit cur, nxt, nn; int ui = 0;
    if (!S.next(0, cur)) return;
    bool has_next = S.next(1, nxt);
    unsigned offc[4], offn[4], offnn[4];
    S.rows(cur, R0, offc);
    if (has_next) S.rows(nxt, R0, offn); else { _Pragma("unroll") for (int j = 0; j < 4; ++j) offn[j] = offc[j]; }
#pragma unroll
    for (int j = 0; j < 4; ++j) { offc[j] += coff; if (has_next) offn[j] += coff; else offn[j] = offc[j]; }
    if constexpr (Sched::GATHER) { PG8_PIN4(offc); PG8_PIN4(offn); }
    f32x4 acc[2][2][4][2];
#pragma unroll
    for (int a = 0; a < 2; ++a)
#pragma unroll
        for (int b = 0; b < 2; ++b)
#pragma unroll
            for (int m = 0; m < 4; ++m)
#pragma unroll
                for (int n = 0; n < 2; ++n) acc[a][b][m][n] = (f32x4){0.f, 0.f, 0.f, 0.f};
    i32x8 At[4], B0[2], B1[2];
    const char* cA = cur.A; const char* cB = cur.B;
    PG8_STAGE_B(PG8_SB(0, 0), cB); PG8_STAGE_B(PG8_SB(0, 1), cB + hstep); PG8_STAGE_A(PG8_SA(0, 0), cA, offc, 0); PG8_STAGE_A(PG8_SA(0, 1), cA, offc, 1);
    if (wr == 1) PG8_BAR;
    PG8_WAIT_V(2); PG8_BAR;
    PG8_STAGE_B(PG8_SB(1, 0), cB + kstep); PG8_STAGE_A(PG8_SA(1, 0), cA + kstep, offc, 0); PG8_STAGE_B(PG8_SB(1, 1), cB + hstep + kstep);
    PG8_WAIT_V(6); PG8_BAR;
    for (;;) {
        const char* nA = has_next ? nxt.A : cA; const char* nB = has_next ? nxt.B : cB;
#pragma nounroll
        for (int t = 0; t < nt; t += 2) {
            const bool last = (t == nt - 2);
            const char* a1 = cA + (size_t)(t + 1) * kstep;
            const char* a2 = last ? nA : cA + (size_t)(t + 2) * kstep; const char* b2 = last ? nB : cB + (size_t)(t + 2) * kstep;
            const char* a3 = a2 + kstep; const char* b3 = b2 + kstep;
            unsigned o2[4];
#pragma unroll
            for (int j = 0; j < 4; ++j) o2[j] = Sched::GATHER ? (last ? offn[j] : offc[j]) : offc[j];
            PG8_LDB(B0, 0, 0); PG8_LDB(B1, 0, 1); PG8_SCHED; PG8_LDA(At, 0, 0); PG8_STAGE_A(PG8_SA(1, 1), a1, offc, 1);
            PG8_WAIT_V(8); PG8_WAIT_L(0); PG8_BAR; PG8_MMA(0, 0, At, B0); PG8_MMA(0, 1, At, B1); PG8_BAR; PG8_SCHED;
            PG8_LDA(At, 0, 1); PG8_STAGE_B(PG8_SB(0, 0), b2); PG8_STAGE_B(PG8_SB(0, 1), b2 + hstep); PG8_STAGE_A(PG8_SA(0, 0), a2, o2, 0);
            PG8_WAIT_V(8); PG8_WAIT_L(0); PG8_BAR; PG8_MMA(1, 0, At, B0); PG8_MMA(1, 1, At, B1); PG8_BAR; PG8_SCHED;
            PG8_LDB(B0, 1, 0); PG8_LDB(B1, 1, 1); PG8_SCHED; PG8_LDA(At, 1, 0); PG8_STAGE_A(PG8_SA(0, 1), a2, o2, 1);
            PG8_WAIT_V(8); PG8_WAIT_L(0); PG8_BAR; PG8_MMA(0, 0, At, B0); PG8_MMA(0, 1, At, B1); PG8_BAR; PG8_SCHED;
            PG8_LDA(At, 1, 1); PG8_STAGE_B(PG8_SB(1, 0), b3); PG8_STAGE_B(PG8_SB(1, 1), b3 + hstep); PG8_STAGE_A(PG8_SA(1, 0), a3, o2, 0);
            PG8_WAIT_V(8); PG8_WAIT_L(0); PG8_BAR; PG8_MMA(1, 0, At, B0); PG8_MMA(1, 1, At, B1); PG8_BAR; PG8_SCHED;
        }
        if constexpr (FP8) asm volatile("s_nop 15\n\ts_nop 15" ::: "memory");
        if (wr == 0) PG8_BAR;
        bool has2 = false;
        if (has_next) { has2 = S.next(ui + 2, nn); if (has2) { S.rows(nn, R0, offnn); } }
        { int fr_e = fr, fq_e = fq; asm volatile("" : "+v"(fr_e), "+v"(fq_e));
          E(acc, cur, wr, wc, fr_e, fq_e); }
        if (!has_next) break;
#pragma unroll
        for (int a = 0; a < 2; ++a)
#pragma unroll
            for (int b = 0; b < 2; ++b)
#pragma unroll
                for (int m = 0; m < 4; ++m)
#pragma unroll
                    for (int n = 0; n < 2; ++n) acc[a][b][m][n] = (f32x4){0.f, 0.f, 0.f, 0.f};
        cur = nxt; cA = nA; cB = nB; ++ui;
#pragma unroll
        for (int j = 0; j < 4; ++j) { offc[j] = offn[j]; if (has2) offn[j] = offnn[j] + coff; }
        if (has2) nxt = nn;
        has_next = has2;
        if constexpr (Sched::GATHER) { PG8_PIN4(offn); }
        if (wr == 1) PG8_BAR;
    }
    PG8_WAIT_V(0);
    PG8_BAR;
#undef PG8_SA
#undef PG8_SB
#undef PG8_STAGE_A
#undef PG8_STAGE_B
#undef PG8_LDA
#undef PG8_LDB
#undef PG8_MMA
#undef PG8_WAIT_V
#undef PG8_WAIT_L
#undef PG8_BAR
#undef PG8_SCHED
#undef PG8_PIN4
}
}

#define XB_TMO      128
#define XB_XCNT(j)  (256  + 64 * (j))
#define XB_XSUB(j)  (1280 + 64 * (j))
#define XB_XGEN(j)  (2304 + 64 * (j))
#define XB_TOP      3328
#define XB_TOPGEN   3392
#define XCD_BAR_WORDS 3456
#define XB_SPIN_CAP (1u << 18)
__device__ __forceinline__ unsigned xb_ld(unsigned* p)              { return __hip_atomic_load(p, __ATOMIC_RELAXED, __HIP_MEMORY_SCOPE_AGENT); }
__device__ __forceinline__ unsigned xb_add(unsigned* p, unsigned v) { return __hip_atomic_fetch_add(p, v, __ATOMIC_RELAXED, __HIP_MEMORY_SCOPE_AGENT); }
__device__ __forceinline__ unsigned xb_xcc_id() { return (unsigned)__builtin_amdgcn_s_getreg((3 << 11) | 20) & 0xFu; }
#define XB_SPIN(cond, bar) do { unsigned _sp = 0; while (cond) { __builtin_amdgcn_s_sleep(1); \
    if ((++_sp & 255u) == 0u) { if (xb_ld(&(bar)[XB_TMO])) break; if (_sp > XB_SPIN_CAP) { atomicAdd(&(bar)[XB_TMO], 1u); break; } } } } while (0)
struct XcdBarrier { unsigned* bar; unsigned x; volatile LAS unsigned* st; };
__device__ __forceinline__ XcdBarrier xcd_barrier_post(unsigned* bar, volatile LAS unsigned* st) {
    XcdBarrier b; b.bar = bar; b.x = xb_xcc_id(); b.st = st;
    if (threadIdx.x == 0) (void)xb_add(&bar[XB_XCNT(b.x)], 1u);
    return b;
}
__device__ __forceinline__ void xcd_barrier_complete(unsigned* bar, unsigned x, unsigned& nloc, unsigned& nx) {
    const unsigned G = gridDim.x * gridDim.y * gridDim.z;
    unsigned sum, cnt, mine, sp = 0u;
    for (;;) {
        sum = 0u; cnt = 0u; mine = 0u;
#pragma unroll
        for (unsigned j = 0; j < 16; ++j) { const unsigned c = xb_ld(&bar[XB_XCNT(j)]); sum += c; cnt += (c > 0u) ? 1u : 0u; mine = (j == x) ? c : mine; }
        if (sum == G) break;
        __builtin_amdgcn_s_sleep(1);
        if ((++sp & 255u) == 0u) { if (xb_ld(&bar[XB_TMO])) break; if (sp > XB_SPIN_CAP) { atomicAdd(&bar[XB_TMO], 1u); break; } }
    }
    nloc = mine > 0u ? mine : 1u; nx = cnt > 0u ? cnt : 1u;
}
__device__ __forceinline__ void xcd_barrier(const XcdBarrier& b) {
    asm volatile("s_waitcnt vmcnt(0)" ::: "memory");
    __syncthreads();
    if (threadIdx.x == 0) {
        unsigned* bar = b.bar;
        __builtin_amdgcn_s_waitcnt(0);
        unsigned nloc = b.st[0], nx = b.st[1];
        if (nloc == 0u) { xcd_barrier_complete(bar, b.x, nloc, nx); b.st[0] = nloc; b.st[1] = nx; }
        const unsigned old = xb_add(&bar[XB_XSUB(b.x)], 1u);
        const unsigned gen = old / nloc;
        if (old + 1u == (gen + 1u) * nloc) {
            __builtin_amdgcn_fence(__ATOMIC_RELEASE, "agent");
            asm volatile("s_waitcnt vmcnt(0)" ::: "memory");
            const unsigned og = xb_add(&bar[XB_TOP], 1u);
            const unsigned tg = og / nx;
            if (og + 1u == (tg + 1u) * nx) xb_add(&bar[XB_TOPGEN], 1u);
            else XB_SPIN(xb_ld(&bar[XB_TOPGEN]) == tg, bar);
            __builtin_amdgcn_fence(__ATOMIC_ACQUIRE, "agent");
            xb_add(&bar[XB_XGEN(b.x)], 1u);
            asm volatile("s_waitcnt vmcnt(0)" ::: "memory");
        } else {
            XB_SPIN(xb_ld(&bar[XB_XGEN(b.x)]) == gen, bar);
            __builtin_amdgcn_fence(__ATOMIC_ACQUIRE, "agent");
            asm volatile("s_waitcnt vmcnt(0)" ::: "memory");
        }
    }
    __syncthreads();
}

struct Args {
    const float* x; const float* p; const float* w_in; const float* pool_mix; const float* pool_scale; const float* conv_w; const float* w_out;
    const float* ln1_g; const float* ln1_b; const float* router_w; const float* router_b; const float* w_gu; const float* b_gu; const float* w_dn; const float* b_dn;
    const float* ln2_g; const float* ln2_b; const float* ple_proj; const float* ple_gate_w; const float* ple_gate_b; const float* ln3_g; const float* ln3_b;
    float* out; unsigned char* ws; int ph_lo, ph_hi;
};
struct Frame { LAS unsigned char* lds; int tid, lane, wave, vcu, G; };

__device__ __forceinline__ void tr_item(const float* src, int ld_src, bf16_t* dst, int ld_dst, LAS float* scr, int lane) {
    const int kr = lane >> 3, nq = lane & 7;
    f32x4 v[8];
#pragma unroll
    for (int r = 0; r < 8; ++r) v[r] = *(const f32x4*)(src + (size_t)(8 * r + kr) * ld_src + 4 * nq);
#pragma unroll
    for (int r = 0; r < 8; ++r)
#pragma unroll
        for (int q = 0; q < 4; ++q) scr[(8 * r + kr) * 33 + 4 * nq + q] = v[r][q];
    LDS_WAIT(); asm volatile("" ::: "memory");
    const int c = lane & 7;
#pragma unroll
    for (int j = 0; j < 4; ++j) { const int n = (lane >> 3) + 8 * j; const LAS float* s = scr + (8 * c) * 33 + n;
        u32x4 o; o.x = cvt_pk_bf16(s[0 * 33], s[1 * 33]); o.y = cvt_pk_bf16(s[2 * 33], s[3 * 33]); o.z = cvt_pk_bf16(s[4 * 33], s[5 * 33]); o.w = cvt_pk_bf16(s[6 * 33], s[7 * 33]);
        *(u32x4*)(dst + (size_t)n * ld_dst + 8 * c) = o; }
    LDS_WAIT(); asm volatile("" ::: "memory");
}
__device__ __forceinline__ void tr_item_fp8(const float* src, int ld_src, unsigned char* dst, int ld_dst, float mul, LAS float* scr, int lane) {
    const int kr = lane >> 3, nq = lane & 7;
    f32x4 v[8];
#pragma unroll
    for (int r = 0; r < 8; ++r) v[r] = *(const f32x4*)(src + (size_t)(8 * r + kr) * ld_src + 4 * nq);
#pragma unroll
    for (int r = 0; r < 8; ++r)
#pragma unroll
        for (int q = 0; q < 4; ++q) scr[(8 * r + kr) * 33 + 4 * nq + q] = v[r][q] * mul;
    LDS_WAIT(); asm volatile("" ::: "memory");
    const int c = lane & 7;
#pragma unroll
    for (int j = 0; j < 4; ++j) { const int n = (lane >> 3) + 8 * j; const LAS float* s = scr + (8 * c) * 33 + n;
        u32x2 o; o.x = cvt4_fp8(s[0 * 33], s[1 * 33], s[2 * 33], s[3 * 33]); o.y = cvt4_fp8(s[4 * 33], s[5 * 33], s[6 * 33], s[7 * 33]);
        *(u32x2*)(dst + (size_t)n * ld_dst + 8 * c) = o; }
    LDS_WAIT(); asm volatile("" ::: "memory");
}
__device__ __forceinline__ void fold_item(const Args& a, bf16_t* W2T, LAS float* scr, int item, int lane) {
    const int g = item >> 8, cb = (item >> 4) & 15, nb = item & 15, c0 = cb * 8, n = nb * 64 + lane;
#pragma unroll
    for (int i = 0; i < 16; ++i) { const int idx = i * 64 + lane, c = idx >> 7, d = idx & 127; scr[d * 8 + c] = a.pool_mix[(size_t)(g * 128 + c0 + c) * 128 + d]; }
    LDS_WAIT(); asm volatile("" ::: "memory");
    float acc[8];
#pragma unroll
    for (int c = 0; c < 8; ++c) acc[c] = 0.f;
#pragma unroll 4
    for (int d = 0; d < 128; ++d) {
        const float wv = a.w_out[(size_t)(g * 128 + d) * D + n] * a.pool_scale[g * 128 + d];
        const f32x4 p0 = *(const LAS f32x4*)(scr + d * 8), p1 = *(const LAS f32x4*)(scr + d * 8 + 4);
        acc[0] += p0[0] * wv; acc[1] += p0[1] * wv; acc[2] += p0[2] * wv; acc[3] += p0[3] * wv;
        acc[4] += p1[0] * wv; acc[5] += p1[1] * wv; acc[6] += p1[2] * wv; acc[7] += p1[3] * wv;
    }
    u32x4 o; o.x = cvt_pk_bf16(acc[0], acc[1]); o.y = cvt_pk_bf16(acc[2], acc[3]); o.z = cvt_pk_bf16(acc[4], acc[5]); o.w = cvt_pk_bf16(acc[6], acc[7]);
    *(u32x4*)(W2T + (size_t)n * D + g * 128 + c0) = o;
    LDS_WAIT(); asm volatile("" ::: "memory");
}
__device__ __forceinline__ void p0_prologue(const Frame& F, const Args& a) {
    unsigned char* ws = a.ws;
    LAS float* scr = (LAS float*)(F.lds + F.wave * 16384);
    const int gw = F.vcu * 8 + F.wave, NGW = F.G * 8;
    bf16_t* WinT = (bf16_t*)(ws + WS_WIN); bf16_t* W2T = (bf16_t*)(ws + WS_W2); bf16_t* WgT = (bf16_t*)(ws + WS_WG); bf16_t* WpT = (bf16_t*)(ws + WS_WP);
    unsigned char* WguT = ws + WS_WGU; unsigned char* WdnT = ws + WS_WDN;
    constexpr int I_FOLD = 1024, I_IN = 16 * 64, I_OUT = 8 * 32, I_G = 16 * 32, I_P = 4 * 32, I_GU = NE * 16 * 64, I_DN = NE * 16 * 32;
    constexpr int NITEMS = I_FOLD + I_IN + I_OUT + I_G + I_P + I_GU + I_DN;
    for (int it = gw; it < NITEMS; it += NGW) {
        int r = it;
        if (r < I_FOLD) { fold_item(a, W2T, scr, r, F.lane); continue; } r -= I_FOLD;
        if (r < I_IN) { const int kb = r >> 6, nb = r & 63; tr_item(a.w_in + (size_t)(64 * kb) * DIN + 32 * nb, DIN, WinT + (size_t)(32 * nb) * D + 64 * kb, D, scr, F.lane); continue; } r -= I_IN;
        if (r < I_OUT) { const int kb = r >> 5, nb = r & 31; tr_item(a.w_out + (size_t)(DPOOL + 64 * kb) * D + 32 * nb, D, W2T + (size_t)(32 * nb) * D + DPOOL + 64 * kb, D, scr, F.lane); continue; } r -= I_OUT;
        if (r < I_G) { const int kb = r >> 5, nb = r & 31; tr_item(a.ple_gate_w + (size_t)(64 * kb) * D + 32 * nb, D, WgT + (size_t)(32 * nb) * D + 64 * kb, D, scr, F.lane); continue; } r -= I_G;
        if (r < I_P) { const int kb = r >> 5, nb = r & 31; tr_item(a.ple_proj + (size_t)(64 * kb) * D + 32 * nb, D, WpT + (size_t)(32 * nb) * PLE + 64 * kb, PLE, scr, F.lane); continue; } r -= I_P;
        if (r < I_GU) { const int e = r >> 10, q = r & 1023, kb = q >> 6, nb = q & 63, n0 = 32 * nb;
            const int h = n0 >> 10, j = n0 & 1023, drow = (j >> 7) * 256 + h * 128 + (j & 127);
            tr_item_fp8(a.w_gu + ((size_t)e * D + 64 * kb) * (2 * FF) + n0, 2 * FF, WguT + ((size_t)e * (2 * FF) + drow) * D + 64 * kb, D, WGU_MUL, scr, F.lane); continue; } r -= I_GU;
        { const int e = r >> 9, q = r & 511, kb = q >> 5, nb = q & 31;
            tr_item_fp8(a.w_dn + ((size_t)e * FF + 64 * kb) * D + 32 * nb, D, WdnT + ((size_t)e * D + 32 * nb) * FF + 64 * kb, FF, WDN_MUL, scr, F.lane); }
    }
    const size_t gt = (size_t)F.vcu * 512 + F.tid, NT = (size_t)F.G * 512;
    { const f32x4* s = (const f32x4*)a.x; u32x4* d = (u32x4*)(ws + WS_XB);
        for (size_t i = gt; i < (size_t)M * D / 8; i += NT) { const f32x4 v0 = s[2 * i], v1 = s[2 * i + 1]; u32x4 o; o.x = cvt_pk_bf16(v0[0], v0[1]); o.y = cvt_pk_bf16(v0[2], v0[3]); o.z = cvt_pk_bf16(v1[0], v1[1]); o.w = cvt_pk_bf16(v1[2], v1[3]); d[i] = o; } }
    { const f32x4* s = (const f32x4*)a.p; u32x4* d = (u32x4*)(ws + WS_PB);
        for (size_t i = gt; i < (size_t)M * PLE / 8; i += NT) { const f32x4 v0 = s[2 * i], v1 = s[2 * i + 1]; u32x4 o; o.x = cvt_pk_bf16(v0[0], v0[1]); o.y = cvt_pk_bf16(v0[2], v0[3]); o.z = cvt_pk_bf16(v1[0], v1[1]); o.w = cvt_pk_bf16(v1[2], v1[3]); d[i] = o; } }
}

__device__ __forceinline__ void unpack8(const u32x4 w, float (&f)[8]) { f[0] = bf_lo(w.x); f[1] = bf_hi(w.x); f[2] = bf_lo(w.y); f[3] = bf_hi(w.y); f[4] = bf_lo(w.z); f[5] = bf_hi(w.z); f[6] = bf_lo(w.w); f[7] = bf_hi(w.w); }
template <int W>
__device__ __forceinline__ void pool_item(const bf16_t* proj, bf16_t* A2, int t0, int g, int lane) {
    const int cb = lane & 15, ts = lane >> 4, tb = t0 + 16 * ts, c = g * 128 + cb * 8, seq0 = tb & ~(SEQ - 1);
    u32x4 rows[15 + W];
#pragma unroll
    for (int i = 0; i < 15 + W; ++i) { const int tr = tb - (W - 1) + i; const int trc = tr < seq0 ? seq0 : tr; rows[i] = *(const u32x4*)(proj + (size_t)trc * DIN + c); }
#pragma unroll
    for (int i = 0; i < W - 1; ++i) { const int tr = tb - (W - 1) + i; if (tr < seq0) rows[i] = (u32x4){0u, 0u, 0u, 0u}; }
    float S[8];
#pragma unroll
    for (int q = 0; q < 8; ++q) S[q] = 0.f;
#pragma unroll
    for (int i = 0; i < W - 1; ++i) { float f[8]; unpack8(rows[i], f);
#pragma unroll
        for (int q = 0; q < 8; ++q) S[q] += f[q]; }
#pragma unroll
    for (int j = 0; j < 16; ++j) { float cur[8], old[8]; unpack8(rows[j + W - 1], cur); unpack8(rows[j], old);
        const int sp1 = tb + j - seq0 + 1; const float inv = sp1 >= W ? (1.0f / (float)W) : (1.0f / (float)sp1); float o[8];
#pragma unroll
        for (int q = 0; q < 8; ++q) { S[q] += cur[q]; o[q] = S[q] * inv - cur[q]; S[q] -= old[q]; }
        u32x4 w; w.x = cvt_pk_bf16(o[0], o[1]); w.y = cvt_pk_bf16(o[2], o[3]); w.z = cvt_pk_bf16(o[4], o[5]); w.w = cvt_pk_bf16(o[6], o[7]);
        *(u32x4*)(A2 + (size_t)(tb + j) * D + c) = w; }
}
__device__ __forceinline__ void conv_item(const bf16_t* proj, bf16_t* A2, const float (&cw)[3][8], int tb, int lane) {
    const int c = 8 * lane, seq0 = tb & ~(SEQ - 1);
    u32x4 rc[10], rv[10], rb[8];
#pragma unroll
    for (int i = 0; i < 10; ++i) { const int tr = tb - 2 + i; const int trc = tr < seq0 ? seq0 : tr; const bf16_t* rp = proj + (size_t)trc * DIN + c; rc[i] = *(const u32x4*)(rp + 1024); rv[i] = *(const u32x4*)(rp + 1536); }
#pragma unroll
    for (int j = 0; j < 8; ++j) rb[j] = *(const u32x4*)(proj + (size_t)(tb + j) * DIN + 512 + c);
    float u[3][8];
#pragma unroll
    for (int i = 0; i < 2; ++i) { float fc[8], fv[8]; unpack8(rc[i], fc); unpack8(rv[i], fv); const bool ok = (tb - 2 + i) >= seq0;
#pragma unroll
        for (int q = 0; q < 8; ++q) u[i][q] = ok ? fc[q] * fv[q] : 0.f; }
#pragma unroll
    for (int j = 0; j < 8; ++j) { float fc[8], fv[8], fb[8], y[8]; unpack8(rc[j + 2], fc); unpack8(rv[j + 2], fv); unpack8(rb[j], fb);
#pragma unroll
        for (int q = 0; q < 8; ++q) { u[2][q] = fc[q] * fv[q]; y[q] = fb[q] * (cw[0][q] * u[0][q] + cw[1][q] * u[1][q] + cw[2][q] * u[2][q]); u[0][q] = u[1][q]; u[1][q] = u[2][q]; }
        u32x4 w; w.x = cvt_pk_bf16(y[0], y[1]); w.y = cvt_pk_bf16(y[2], y[3]); w.z = cvt_pk_bf16(y[4], y[5]); w.w = cvt_pk_bf16(y[6], y[7]);
        *(u32x4*)(A2 + (size_t)(tb + j) * D + DPOOL + c) = w; }
}
__device__ __forceinline__ void p2_mixer(const Frame& F, const Args& a) {
    const bf16_t* proj = (const bf16_t*)(a.ws + WS_PROJ); bf16_t* A2 = (bf16_t*)(a.ws + WS_A2);
    const int gw = F.vcu * 8 + F.wave, NGW = F.G * 8;
    for (int it = gw; it < 4 * (M / 64); it += NGW) { const int g = it & 3, t0 = (it >> 2) * 64;
        if (g == 0) pool_item<2>(proj, A2, t0, 0, F.lane); else if (g == 1) pool_item<4>(proj, A2, t0, 1, F.lane); else if (g == 2) pool_item<8>(proj, A2, t0, 2, F.lane); else pool_item<16>(proj, A2, t0, 3, F.lane); }
    float cw[3][8];
#pragma unroll
    for (int k = 0; k < 3; ++k)
#pragma unroll
        for (int i = 0; i < 8; ++i) cw[k][i] = a.conv_w[k * DPOOL + 8 * F.lane + i];
    for (int it = gw; it < M / 8; it += NGW) conv_item(proj, A2, cw, it * 8, F.lane);
}

__device__ __forceinline__ void load_row16(const float* rp, int lane, float (&v)[16]) {
#pragma unroll
    for (int j = 0; j < 2; ++j) { const f32x4 a0 = *(const f32x4*)(rp + 8 * lane + 512 * j), a1 = *(const f32x4*)(rp + 8 * lane + 512 * j + 4);
#pragma unroll
        for (int i = 0; i < 4; ++i) { v[8 * j + i] = a0[i]; v[8 * j + 4 + i] = a1[i]; } }
}
__device__ __forceinline__ void store_row16(float* rp, int lane, const float (&v)[16]) {
#pragma unroll
    for (int j = 0; j < 2; ++j) { *(f32x4*)(rp + 8 * lane + 512 * j) = (f32x4){v[8 * j], v[8 * j + 1], v[8 * j + 2], v[8 * j + 3]}; *(f32x4*)(rp + 8 * lane + 512 * j + 4) = (f32x4){v[8 * j + 4], v[8 * j + 5], v[8 * j + 6], v[8 * j + 7]}; }
}
__device__ __forceinline__ void unpack_row16(const u32x4 (&w)[2], float (&v)[16]) {
#pragma unroll
    for (int j = 0; j < 2; ++j) { v[8 * j] = bf_lo(w[j].x); v[8 * j + 1] = bf_hi(w[j].x); v[8 * j + 2] = bf_lo(w[j].y); v[8 * j + 3] = bf_hi(w[j].y); v[8 * j + 4] = bf_lo(w[j].z); v[8 * j + 5] = bf_hi(w[j].z); v[8 * j + 6] = bf_lo(w[j].w); v[8 * j + 7] = bf_hi(w[j].w); }
}
__device__ __forceinline__ void load_row16_bfw(const bf16_t* rp, int lane, u32x4 (&w)[2]) { w[0] = *(const u32x4*)(rp + 8 * lane); w[1] = *(const u32x4*)(rp + 8 * lane + 512); }
__device__ __forceinline__ void store_row16_bf(bf16_t* rp, int lane, const float (&v)[16]) {
#pragma unroll
    for (int j = 0; j < 2; ++j) { u32x4 o; o.x = cvt_pk_bf16(v[8 * j], v[8 * j + 1]); o.y = cvt_pk_bf16(v[8 * j + 2], v[8 * j + 3]); o.z = cvt_pk_bf16(v[8 * j + 4], v[8 * j + 5]); o.w = cvt_pk_bf16(v[8 * j + 6], v[8 * j + 7]); *(u32x4*)(rp + 8 * lane + 512 * j) = o; }
}
__device__ __forceinline__ void ln_row16(float (&v)[16], const float (&g)[16], const float (&b)[16]) {
    float s = 0.f;
#pragma unroll
    for (int i = 0; i < 16; ++i) s += v[i];
    const float mean = wave_sum(s) * (1.0f / D); float q = 0.f;
#pragma unroll
    for (int i = 0; i < 16; ++i) { v[i] -= mean; q += v[i] * v[i]; }
    const float rstd = 1.0f / sqrtf(wave_sum(q) * (1.0f / D) + LN_EPS);
#pragma unroll
    for (int i = 0; i < 16; ++i) v[i] = v[i] * rstd * g[i] + b[i];
}

__device__ __forceinline__ void ln_rows2(float (&v)[2][16], const float (&g)[16], const float (&b)[16]) {
    float s0 = 0.f, s1 = 0.f;
#pragma unroll
    for (int i = 0; i < 16; ++i) { s0 += v[0][i]; s1 += v[1][i]; }
#pragma unroll
    for (int o = 1; o < 64; o <<= 1) { s0 += __shfl_xor(s0, o); s1 += __shfl_xor(s1, o); }
    const float m0 = s0 * (1.0f / D), m1 = s1 * (1.0f / D); float q0 = 0.f, q1 = 0.f;
#pragma unroll
    for (int i = 0; i < 16; ++i) { v[0][i] -= m0; v[1][i] -= m1; q0 += v[0][i] * v[0][i]; q1 += v[1][i] * v[1][i]; }
#pragma unroll
    for (int o = 1; o < 64; o <<= 1) { q0 += __shfl_xor(q0, o); q1 += __shfl_xor(q1, o); }
    const float r0 = 1.0f / sqrtf(q0 * (1.0f / D) + LN_EPS), r1 = 1.0f / sqrtf(q1 * (1.0f / D) + LN_EPS);
#pragma unroll
    for (int i = 0; i < 16; ++i) { v[0][i] = v[0][i] * r0 * g[i] + b[i]; v[1][i] = v[1][i] * r1 * g[i] + b[i]; }
}
constexpr int XPITCH = 2064;
constexpr int L_XHI = 0, L_XLO = 16 * XPITCH, L_PART = 2 * 16 * XPITCH  ;
__device__ __forceinline__ void p4_ln1_router(const Frame& F, const Args& a) {
    bf16_t* X1B = (bf16_t*)(a.ws + WS_XB1); unsigned char* X1F8 = a.ws + WS_X1F8; float* TG = (float*)(a.ws + WS_TG); int* LIST = (int*)(a.ws + WS_LIST);
    unsigned* gcnt = (unsigned*)(a.ws + WS_CTL) + CW_CNT;
    LAS unsigned* lhist = (LAS unsigned*)(F.lds + L_HIST); LAS unsigned* lbase = (LAS unsigned*)(F.lds + L_BASE); LAS unsigned* asg = (LAS unsigned*)(F.lds + L_ASG);
    const int lane = F.lane, w = F.wave, fr = lane & 15, fq = lane >> 4;
    if (F.tid < 32) lhist[F.tid] = 0u;
    float g[16], b[16];
    load_row16(a.ln1_g, lane, g); load_row16(a.ln1_b, lane, b);
    bf16x8 bhi[4][2], blo[4][2];
#pragma unroll
    for (int ks = 0; ks < 4; ++ks)
#pragma unroll
        for (int h = 0; h < 2; ++h) { unsigned hw[4], lw[4];
#pragma unroll
            for (int i2 = 0; i2 < 4; ++i2) { const int k = 128 * w + 32 * ks + 8 * fq + 2 * i2; const float v0 = a.router_w[(size_t)k * NE + 16 * h + fr], v1 = a.router_w[(size_t)(k + 1) * NE + 16 * h + fr];
                const unsigned hp = cvt_pk_bf16(v0, v1); const float r0 = v0 - bf_lo(hp), r1 = v1 - bf_hi(hp); hw[i2] = hp; lw[i2] = cvt_pk_bf16(r0, r1); }
            bhi[ks][h] = __builtin_bit_cast(bf16x8, (u32x4){hw[0], hw[1], hw[2], hw[3]}); blo[ks][h] = __builtin_bit_cast(bf16x8, (u32x4){lw[0], lw[1], lw[2], lw[3]}); }
    const float rbias = a.router_b[F.tid & 31];
    __syncthreads();
    int gl = 0;
    u32x4 vn[2][2];
#pragma unroll
    for (int rr = 0; rr < 2; ++rr) load_row16_bfw(X1B + (size_t)(F.vcu * 16 + 2 * w + rr) * D, lane, vn[rr]);
    for (int grp = F.vcu; grp < M / 16; grp += F.G, ++gl) {
        const int row0 = grp * 16;
        float v2[2][16];
#pragma unroll
        for (int rr = 0; rr < 2; ++rr) unpack_row16(vn[rr], v2[rr]);
        if (grp + F.G < M / 16) {
#pragma unroll
            for (int rr = 0; rr < 2; ++rr) load_row16_bfw(X1B + (size_t)((grp + F.G) * 16 + 2 * w + rr) * D, lane, vn[rr]); }
        ln_rows2(v2, g, b);
#pragma unroll
        for (int rr = 0; rr < 2; ++rr) { const int rl = 2 * w + rr; float (&v)[16] = v2[rr];
#pragma unroll
            for (int j = 0; j < 2; ++j) { unsigned hw[4], lw[4];
#pragma unroll
                for (int i2 = 0; i2 < 4; ++i2) { const float v0 = v[8 * j + 2 * i2], v1 = v[8 * j + 2 * i2 + 1]; const unsigned hp = cvt_pk_bf16(v0, v1); hw[i2] = hp; lw[i2] = cvt_pk_bf16(v0 - bf_lo(hp), v1 - bf_hi(hp)); }
                const u32x4 hv = {hw[0], hw[1], hw[2], hw[3]}, lv = {lw[0], lw[1], lw[2], lw[3]};
                *(u32x4*)(X1B + (size_t)(row0 + rl) * D + 8 * lane + 512 * j) = hv;
                { u32x2 f8; f8.x = cvt4_fp8(v[8 * j], v[8 * j + 1], v[8 * j + 2], v[8 * j + 3]); f8.y = cvt4_fp8(v[8 * j + 4], v[8 * j + 5], v[8 * j + 6], v[8 * j + 7]); *(u32x2*)(X1F8 + (size_t)(row0 + rl) * D + 8 * lane + 512 * j) = f8; }
                *(LAS u32x4*)(F.lds + L_XHI + rl * XPITCH + (8 * lane + 512 * j) * 2) = hv; *(LAS u32x4*)(F.lds + L_XLO + rl * XPITCH + (8 * lane + 512 * j) * 2) = lv; } }
        __syncthreads();
        f32x4 acc[2] = {(f32x4){0.f, 0.f, 0.f, 0.f}, (f32x4){0.f, 0.f, 0.f, 0.f}};
#pragma unroll
        for (int ks = 0; ks < 4; ++ks) { const int ko = (128 * w + 32 * ks + 8 * fq) * 2;
            const bf16x8 ahi = *(const LAS bf16x8*)(F.lds + L_XHI + fr * XPITCH + ko), alo = *(const LAS bf16x8*)(F.lds + L_XLO + fr * XPITCH + ko);
#pragma unroll
            for (int h = 0; h < 2; ++h) { acc[h] = __builtin_amdgcn_mfma_f32_16x16x32_bf16(bhi[ks][h], ahi, acc[h], 0, 0, 0); acc[h] = __builtin_amdgcn_mfma_f32_16x16x32_bf16(blo[ks][h], ahi, acc[h], 0, 0, 0);
                acc[h] = __builtin_amdgcn_mfma_f32_16x16x32_bf16(bhi[ks][h], alo, acc[h], 0, 0, 0); } }
#pragma unroll
        for (int h = 0; h < 2; ++h) *(LAS f32x4*)(F.lds + L_PART + ((w * 16 + fr) * 32 + 16 * h + 4 * fq) * 4) = acc[h];
        __syncthreads();
        { const int rl = F.tid >> 5, e = F.tid & 31; float v = rbias;
#pragma unroll
            for (int ww = 0; ww < 8; ++ww) v += *(const LAS float*)(F.lds + L_PART + ((ww * 16 + rl) * 32 + e) * 4);
            bool taken = false; float sv[4]; int si[4];
#pragma unroll
            for (int r = 0; r < 4; ++r) { float bv = taken ? -__builtin_inff() : v; int bi = e;
#pragma unroll
                for (int mk = 1; mk < 32; mk <<= 1) { const float ov = __shfl_xor(bv, mk); const int oi = __shfl_xor(bi, mk); if (ov > bv || (ov == bv && oi < bi)) { bv = ov; bi = oi; } }
                sv[r] = bv; si[r] = bi; if (bi == e) taken = true; }
            const float p1 = __expf(sv[1] - sv[0]), p2 = __expf(sv[2] - sv[0]), p3 = __expf(sv[3] - sv[0]); const float inv = 1.0f / (1.0f + p1 + p2 + p3);
            if (e < 4) { const float gk = (e == 0 ? 1.0f : e == 1 ? p1 : e == 2 ? p2 : p3) * inv; const int ek = e == 0 ? si[0] : e == 1 ? si[1] : e == 2 ? si[2] : si[3];
                TG[(size_t)(row0 + rl) * 4 + e] = gk;
                const unsigned rank = atomicAdd((unsigned*)(lhist + ek), 1u);
                asg[(gl * 16 + rl) * 4 + e] = ((unsigned)ek << 16) | rank; } }
    }
    __syncthreads();
    if (F.tid < 32) lbase[F.tid] = __hip_atomic_fetch_add(gcnt + F.tid, lhist[F.tid], RLX_AGENT);
    __syncthreads();
    for (int s = F.tid; s < gl * 64; s += 512) { const unsigned av = asg[s]; const int e = av >> 16, rank = av & 0xffff; const int g2 = s >> 6, rl = (s >> 2) & 15, k = s & 3;
        const int tok = (F.vcu + g2 * F.G) * 16 + rl; LIST[(size_t)e * LCAP + lbase[e] + rank] = tok * 4 + k; }
}

__device__ __forceinline__ void moe_tables(const Frame& F, const Args& a, int ncol  ) {
    LAS int* tst = (LAS int*)(F.lds + L_TST); LAS int* lcnt = (LAS int*)(F.lds + L_CNT); LAS int* ut = (LAS int*)(F.lds + L_UT);
    unsigned* gcnt = (unsigned*)(a.ws + WS_CTL) + CW_CNT;
    if (F.tid < 32) lcnt[F.tid] = (int)__hip_atomic_load(gcnt + F.tid, RLX_AGENT);
    __syncthreads();
    if (F.tid == 0) { int s = 0; for (int e = 0; e < NE; ++e) { tst[e] = s; s += (lcnt[e] + 255) >> 8; } tst[NE] = s; }
    __syncthreads();
    if (F.tid < 32) { const int i = F.tid; const int T = tst[NE]; const long L = (long)i * F.G + F.vcu; int e = 0, tile = 0, pn = 0, valid = 0, lb = 0, nv = 0;
        if (L < (long)T * ncol) { tile = (int)(L / ncol); pn = (int)(L % ncol); valid = 1; for (int q = 0; q < NE; ++q) if (tst[q + 1] <= tile) e = q + 1;
            const int tin = tile - tst[e]; lb = e * LCAP + tin * 256; nv = lcnt[e] - tin * 256; nv = nv > 256 ? 256 : nv; }
        ut[i * 8 + 0] = e; ut[i * 8 + 1] = tile; ut[i * 8 + 2] = pn; ut[i * 8 + 3] = valid; ut[i * 8 + 4] = lb; ut[i * 8 + 5] = nv; ut[i * 8 + 6] = 0; ut[i * 8 + 7] = 0; }
    __syncthreads();
}

__device__ __forceinline__ void p7_combine_ln2(const Frame& F, const Args& a) {
    bf16_t* XB = (bf16_t*)(a.ws + WS_XB1); const float* TG = (const float*)(a.ws + WS_TG); const bf16_t* Y = (const bf16_t*)(a.ws + WS_Y);
    const int lane = F.lane, gw = F.vcu * 8 + F.wave, NGW = F.G * 8;
    float g[16], b[16]; load_row16(a.ln2_g, lane, g); load_row16(a.ln2_b, lane, b);
    for (int row = 2 * gw; row < M; row += 2 * NGW) { float v[2][16]; u32x4 xw[2][2], yw[2][4][2]; f32x4 gt[2];
#pragma unroll
        for (int r = 0; r < 2; ++r) { load_row16_bfw(XB + (size_t)(row + r) * D, lane, xw[r]); gt[r] = *(const f32x4*)(TG + (size_t)(row + r) * 4);
#pragma unroll
            for (int k = 0; k < 4; ++k)
#pragma unroll
                for (int j = 0; j < 2; ++j) yw[r][k][j] = *(const u32x4*)(Y + ((size_t)(row + r) * 4 + k) * D + 8 * lane + 512 * j); }
#pragma unroll
        for (int r = 0; r < 2; ++r) { unpack_row16(xw[r], v[r]);
#pragma unroll
            for (int i = 0; i < 16; ++i) v[r][i] *= ALPHA;
#pragma unroll
            for (int k = 0; k < 4; ++k)
#pragma unroll
                for (int j = 0; j < 2; ++j) { float f[8]; unpack8(yw[r][k][j], f);
#pragma unroll
                    for (int i = 0; i < 8; ++i) v[r][8 * j + i] += gt[r][k] * f[i]; } }
        ln_rows2(v, g, b);
#pragma unroll
        for (int r = 0; r < 2; ++r) store_row16_bf(XB + (size_t)(row + r) * D, lane, v[r]); }
}
__device__ __forceinline__ void p9_ln3(const Frame& F, const Args& a) {
    float* R = a.out; const bf16_t* H3 = (const bf16_t*)(a.ws + WS_H3); const int lane = F.lane, gw = F.vcu * 8 + F.wave, NGW = F.G * 8;
    float g[16], b[16]; load_row16(a.ln3_g, lane, g); load_row16(a.ln3_b, lane, b);
    for (int row = 2 * gw; row < M; row += 2 * NGW) { float v[2][16]; u32x4 hw[2][2];
        load_row16_bfw(H3 + (size_t)row * D, lane, hw[0]); load_row16_bfw(H3 + (size_t)(row + 1) * D, lane, hw[1]);
        unpack_row16(hw[0], v[0]); unpack_row16(hw[1], v[1]);
        ln_rows2(v, g, b);
        store_row16(R + (size_t)row * D, lane, v[0]); store_row16(R + (size_t)(row + 1) * D, lane, v[1]); }
}

__global__ void __launch_bounds__(512, 2) fwd_kernel(Args args) {
    extern __shared__ __attribute__((aligned(16))) unsigned char lds_raw[];
    Frame F;
    F.lds = (LAS unsigned char*)lds_raw;
    F.tid = threadIdx.x; F.lane = F.tid & 63; F.wave = __builtin_amdgcn_readfirstlane(F.tid >> 6);
    F.G = gridDim.x; { const int bx = blockIdx.x; F.vcu = (F.G % 8 == 0) ? (bx % 8) * (F.G / 8) + bx / 8 : bx; }
    unsigned char* ws = args.ws;
    volatile LAS unsigned* MISC = (volatile LAS unsigned*)(F.lds + L_MISC);
    for (int u = F.tid; u < (LDS_BYTES - RING_BYTES) / 4; u += 512) ((LAS unsigned*)(F.lds + RING_BYTES))[u] = 0u;
    __syncthreads();
    XcdBarrier bar; bar.bar = (unsigned*)(ws + WS_CTL) + CW_BAR; bar.x = 0; bar.st = nullptr;
    if (MK_N_LAUNCHES == 1) bar = xcd_barrier_post((unsigned*)(ws + WS_CTL) + CW_BAR, MISC + 8);
    const int lo = args.ph_lo, hi = args.ph_hi;
#ifndef PHASE_MASK
#define PHASE_MASK 0x3ff
#endif
#define IN(k) (((PHASE_MASK >> (k)) & 1) && lo <= (k) && (k) < hi)
#define GRID_BAR(k) do { if (IN(k) && IN((k) + 1)) xcd_barrier(bar); } while (0)

    if (IN(0)) { _Pragma("unroll") for (int rep = 0; rep < REP0; ++rep) p0_prologue(F, args); GRID_BAR(0); }

    if (IN(1)) {
        _Pragma("unroll") for (int rep = 0; rep < REP1; ++rep) {
        { pg8::DenseOrder S; S.init(ws + WS_XB, ws + WS_WIN, M, DIN, 2 * D, F.G, (int)blockIdx.x); pg8::EpiBf16 E{(bf16_t*)(ws + WS_PROJ), DIN};
          pg8::gemm_phase<pg8::EpiBf16, pg8::DenseOrder>(F.lds, 2 * D, S, E); }
        { pg8::DenseOrder S; S.init(ws + WS_PB, ws + WS_WP, M, D, 2 * PLE, F.G, (int)blockIdx.x); pg8::EpiBf16 E{(bf16_t*)(ws + WS_PLE), D};
          pg8::gemm_phase<pg8::EpiBf16, pg8::DenseOrder>(F.lds, 2 * PLE, S, E); }
        }
        GRID_BAR(1);
    }

    if (IN(2)) { _Pragma("unroll") for (int rep = 0; rep < REP2; ++rep) p2_mixer(F, args); GRID_BAR(2); }

    if (IN(3)) {
        pg8::DenseOrder S; S.init(ws + WS_A2, ws + WS_W2, M, D, 2 * D, F.G, (int)blockIdx.x); pg8::EpiH1 E{(const bf16_t*)(ws + WS_XB), (bf16_t*)(ws + WS_XB1)};
        _Pragma("unroll") for (int rep = 0; rep < REP3; ++rep) pg8::gemm_phase<pg8::EpiH1, pg8::DenseOrder>(F.lds, 2 * D, S, E);
        GRID_BAR(3);
    }

    if (IN(4)) { p4_ln1_router(F, args); GRID_BAR(4); }

    if (IN(5)) {
        moe_tables(F, args, 8);
        pg8::MoeGuOrder S; S.ut = (const LAS int*)(F.lds + L_UT); S.A = (const char*)(ws + WS_X1F8); S.Bt = (const char*)(ws + WS_WGU); S.list = (const int*)(ws + WS_LIST); S.KB = D; S.bstride_e = (size_t)2 * FF * D; S.gather = true;
        pg8::EpiGU E{(unsigned char*)(ws + WS_HID), args.b_gu};
        _Pragma("unroll") for (int rep = 0; rep < REP5; ++rep) pg8::gemm_phase<pg8::EpiGU, pg8::MoeGuOrder, true>(F.lds, D, S, E, SCL_WGU, 0x7f7f7f7f);
        GRID_BAR(5);
    }

    if (IN(6)) {
        moe_tables(F, args, 4);
        pg8::MoeDnOrder S; S.ut = (const LAS int*)(F.lds + L_UT); S.A = (const char*)(ws + WS_HID); S.Bt = (const char*)(ws + WS_WDN); S.list = (const int*)(ws + WS_LIST); S.KB = FF; S.bstride_e = (size_t)D * FF; S.gather = false;
        pg8::EpiDown E{(bf16_t*)(ws + WS_Y), args.b_dn, (const int*)(ws + WS_LIST)};
        _Pragma("unroll") for (int rep = 0; rep < REP6; ++rep) pg8::gemm_phase<pg8::EpiDown, pg8::MoeDnOrder, true>(F.lds, FF, S, E, SCL_WDN, SCL_HID);
        GRID_BAR(6);
    }

    if (IN(7)) { p7_combine_ln2(F, args); GRID_BAR(7); }

    if (IN(8)) {
        pg8::DenseOrder S; S.init(ws + WS_XB1, ws + WS_WG, M, D, 2 * D, F.G, (int)blockIdx.x); pg8::EpiGate E{(const bf16_t*)(ws + WS_XB1), (const bf16_t*)(ws + WS_PLE), args.ple_gate_b, (bf16_t*)(ws + WS_H3)};
        pg8::gemm_phase<pg8::EpiGate, pg8::DenseOrder>(F.lds, 2 * D, S, E);
        GRID_BAR(8);
    }

    if (IN(9)) { p9_ln3(F, args); }
#undef IN
#undef GRID_BAR
}

extern "C" void kernel_launch(void* const* d_in, const int* in_sizes, int n_in, void* d_out, int out_size, void* d_ws, size_t ws_size, hipStream_t stream) {
    static int grid = 0;
    if (grid == 0) {
        if (n_in != 22 || in_sizes[0] != M * D || out_size != M * D || ws_size < WS_END) { fprintf(stderr, "kernel_launch: unexpected shapes (n_in %d, in0 %d, out %d, ws %zu); nothing launched\n", n_in, n_in > 0 ? in_sizes[0] : -1, out_size, ws_size); grid = -1; return; }
        int dev = 0, cus = 0, per_cu = 0;
        if (hipGetDevice(&dev) != hipSuccess || hipDeviceGetAttribute(&cus, hipDeviceAttributeMultiprocessorCount, dev) != hipSuccess) { grid = -1; return; }
        if (hipFuncSetAttribute((const void*)fwd_kernel, hipFuncAttributeMaxDynamicSharedMemorySize, LDS_BYTES) != hipSuccess) { fprintf(stderr, "kernel_launch: hipFuncSetAttribute failed\n"); grid = -1; return; }
        if (hipOccupancyMaxActiveBlocksPerMultiprocessor(&per_cu, (const void*)fwd_kernel, 512, LDS_BYTES) != hipSuccess || per_cu < 1) fprintf(stderr, "kernel_launch: occupancy query reports %d\n", per_cu);
        (void)hipGetLastError();
        grid = cus;
        if (grid != 256) fprintf(stderr, "kernel_launch: %d CUs (expected 256)\n", grid);
    }
    if (grid < 0) return;
    (void)hipMemsetAsync((char*)d_ws + WS_CTL, 0, CTL_ZERO_BYTES, stream);
    Args a{};
    const float** ap = (const float**)&a;
    for (int i = 0; i < 22; ++i) ap[i] = (const float*)d_in[i];
    a.out = (float*)d_out; a.ws = (unsigned char*)d_ws;
#if MK_N_LAUNCHES == 1
    a.ph_lo = 0; a.ph_hi = NPHASE;
    hipLaunchKernelGGL(fwd_kernel, dim3(grid), dim3(512), LDS_BYTES, stream, a);
#else
    for (int ph = 0; ph < NPHASE; ++ph) { a.ph_lo = ph; a.ph_hi = ph + 1; hipLaunchKernelGGL(fwd_kernel, dim3(grid), dim3(512), LDS_BYTES, stream, a); }
#endif
}
```

```cpp
#include <hip/hip_runtime.h>
#include <cstdio>
#include <cstdint>

#ifndef MK_N_LAUNCHES
#define MK_N_LAUNCHES 1
#endif

#ifndef REP0
#define REP0 1
#endif
#ifndef REP1
#define REP1 1
#endif
#ifndef REP2
#define REP2 1
#endif
#ifndef REP3
#define REP3 1
#endif
#ifndef REP5
#define REP5 1
#endif
#ifndef REP6
#define REP6 1
#endif
#define LAS __attribute__((address_space(3)))
#define GAS __attribute__((address_space(1)))
typedef unsigned short bf16_t;
typedef short bf16x8 __attribute__((ext_vector_type(8)));
typedef float f32x4 __attribute__((ext_vector_type(4)));
typedef float f32x2 __attribute__((ext_vector_type(2)));
typedef unsigned u32x4 __attribute__((ext_vector_type(4)));
typedef unsigned u32x2 __attribute__((ext_vector_type(2)));
typedef int i32x4 __attribute__((ext_vector_type(4)));
typedef int i32x8 __attribute__((ext_vector_type(8)));
typedef GAS unsigned gu32;

constexpr int M = 32768, D = 1024, SEQ = 4096, DIN = 2048, NE = 32, TOPK = 4, FF = 1024, PLE = 256, DPOOL = 512;
constexpr int NA = M * TOPK;
constexpr int LCAP = M;
constexpr int MAXTILES = NA / 256 + NE;
constexpr float ALPHA = 1.189207115002721f;
constexpr float LN_EPS = 1e-5f;
constexpr float SW_LIMIT = 7.0f, SW_ALPHA = 1.702f;
constexpr int NPHASE = 10;
constexpr float WGU_MUL = 32.0f, WDN_MUL = 64.0f, HID_MUL = 4.0f, Y_MUL = 16.0f;
constexpr int SCL_WGU = 0x7a7a7a7a  , SCL_WDN = 0x79797979  , SCL_HID = 0x7d7d7d7d  ;

constexpr size_t MiB = 1u << 20;
constexpr size_t WS_CTL = 0, CTL_ZERO_BYTES = 1 * MiB;
constexpr size_t WS_WIN = 1 * MiB;
constexpr size_t WS_W2 = 5 * MiB;
constexpr size_t WS_WG = 7 * MiB;
constexpr size_t WS_WP = 9 * MiB;
constexpr size_t WS_TG = 10 * MiB;
constexpr size_t WS_LIST = 11 * MiB;
constexpr size_t WS_WGU = 16 * MiB;
constexpr size_t WS_WDN = 144 * MiB;
constexpr size_t WS_XB1 = 208 * MiB;
constexpr size_t WS_PLE = 272 * MiB;
constexpr size_t WS_HID = 336 * MiB;
constexpr size_t WS_PROJ = 336 * MiB;
constexpr size_t WS_A2 = 464 * MiB;
constexpr size_t WS_XB = 528 * MiB;
constexpr size_t WS_PB = 592 * MiB;
constexpr size_t WS_H3 = 336 * MiB;
constexpr size_t WS_Y = 608 * MiB;
constexpr size_t WS_X1F8 = 864 * MiB;
constexpr size_t WS_END = 896 * MiB;
static_assert(WS_HID + (size_t)MAXTILES * 256 * 1024 * 2 <= WS_Y, "hidden fits");
constexpr int CW_TMO = 0, CW_CODE = 1, CW_CNT = 64  , CW_BAR = 4096;

constexpr int RING_BYTES = 131072;
constexpr int L_MISC = RING_BYTES;
constexpr int L_TST = RING_BYTES + 128;
constexpr int L_CNT = RING_BYTES + 272;
constexpr int L_UT = RING_BYTES + 640;
constexpr int L_HIST = RING_BYTES + 1664;
constexpr int L_BASE = RING_BYTES + 1792;
constexpr int L_ASG = RING_BYTES + 2048;
constexpr int LDS_BYTES = 147456;
static_assert(L_ASG + 2048 <= LDS_BYTES, "LDS map");

#define RLX_AGENT __ATOMIC_RELAXED, __HIP_MEMORY_SCOPE_AGENT
#define LDS_WAIT() asm volatile("s_waitcnt lgkmcnt(0)" ::: "memory")
#define VM_WAIT() asm volatile("s_waitcnt vmcnt(0)" ::: "memory")

__device__ __forceinline__ unsigned cvt_pk_bf16(float lo, float hi) { unsigned r; asm volatile("v_cvt_pk_bf16_f32 %0, %1, %2" : "=v"(r) : "v"(lo), "v"(hi)); return r; }
__device__ __forceinline__ unsigned cvt4_fp8(float a, float b, float c, float d) {
    a = __builtin_fminf(__builtin_fmaxf(a, -448.f), 448.f); b = __builtin_fminf(__builtin_fmaxf(b, -448.f), 448.f); c = __builtin_fminf(__builtin_fmaxf(c, -448.f), 448.f); d = __builtin_fminf(__builtin_fmaxf(d, -448.f), 448.f);
    int w = 0; w = __builtin_amdgcn_cvt_pk_fp8_f32(a, b, w, false); w = __builtin_amdgcn_cvt_pk_fp8_f32(c, d, w, true); return (unsigned)w; }
__device__ __forceinline__ float bf_lo(unsigned w) { return __uint_as_float(w << 16); }
__device__ __forceinline__ float bf_hi(unsigned w) { return __uint_as_float(w & 0xffff0000u); }
__device__ __forceinline__ float wave_sum(float v) {
#pragma unroll
    for (int o = 1; o < 64; o <<= 1) v += __shfl_xor(v, o);
    return v;
}

namespace pg8 {
constexpr int BM = 256, BK = 64, HALF = 128, HTB = HALF * BK * 2, STAGE_BYTES = 8 * HTB, NXCD = 8, WGM = 8;
__host__ __device__ __forceinline__ int lds_byte(int r, int c) { const int st = (r >> 4) * 2 + (c >> 5), rr = r & 15, cc = c & 31, ob = rr * 64 + cc * 2; return st * 1024 + (ob ^ (((ob >> 9) & 1) << 5)); }
__host__ __device__ __forceinline__ void stage_rc(int b, int& R, int& C) { const int st = b / 1024, sb = b % 1024, swz = sb ^ (((sb >> 9) & 1) << 5); R = (st >> 1) * 16 + swz / 64; C = (st & 1) * 32 + (swz % 64) / 2; }
__host__ __device__ __forceinline__ int perm32(int rho) { const int n = rho >> 4, i = rho & 15; return 8 * (i >> 2) + 4 * n + (i & 3); }

struct Unit { const char* A; const char* B; int pm, pn, e, lbase, nvalid; };

struct DenseOrder {
    static constexpr bool GATHER = false;
    const char* A; const char* Bt; int KB, nM, nN, nwg, G, c;
    __device__ __forceinline__ void init(const void* A_, const void* Bt_, int M_, int N_, int KB_, int G_, int c_) { A = (const char*)A_; Bt = (const char*)Bt_; KB = KB_; nM = M_ / BM; nN = N_ / BM; nwg = nM * nN; G = G_; c = c_; }
    __device__ __forceinline__ bool next(int i, Unit& u) const {
        const long L = (long)i * G + c; if (L >= nwg) return false;
        int wgid = (int)L; { const int q = nwg / NXCD, r = nwg % NXCD, xcd = wgid % NXCD, off = wgid / NXCD; wgid = (xcd < r ? xcd * (q + 1) : r * (q + 1) + (xcd - r) * q) + off; }
        const int nig = WGM * nN, gid = wgid / nig, fm = gid * WGM, gsz = (nM - fm) < WGM ? (nM - fm) : WGM;
        u.pm = fm + ((wgid % nig) % gsz); u.pn = (wgid % nig) / gsz;
        u.A = A + (size_t)u.pm * BM * KB; u.B = Bt + (size_t)u.pn * BM * KB; u.e = 0; u.lbase = 0; u.nvalid = BM; return true;
    }
    __device__ __forceinline__ void rows(const Unit&, int R0, unsigned (&off)[4]) const {
#pragma unroll
        for (int j = 0; j < 4; ++j) off[j] = (unsigned)((R0 + 64 * j) * KB);
    }
};

struct MoeOrder {
    const LAS int* ut; const char* A; const char* Bt; const int* list; int KB; size_t bstride_e; bool gather;
    __device__ __forceinline__ bool next_(int i, Unit& u) const {
        if (i >= 32) return false;
        const LAS int* t = ut + i * 8;
        const int e = __builtin_amdgcn_readfirstlane(t[0]), tile = __builtin_amdgcn_readfirstlane(t[1]), pn = __builtin_amdgcn_readfirstlane(t[2]), valid = __builtin_amdgcn_readfirstlane(t[3]);
        const int lb = __builtin_amdgcn_readfirstlane(t[4]), nv = __builtin_amdgcn_readfirstlane(t[5]);
        if (!valid) return false;
        u.e = e; u.pm = tile; u.pn = pn; u.lbase = lb; u.nvalid = nv;
        u.B = Bt + (size_t)e * bstride_e + (size_t)pn * BM * KB;
        u.A = gather ? A : A + (size_t)tile * BM * KB;
        return true;
    }
};
struct MoeGuOrder : MoeOrder {
    static constexpr bool GATHER = true;
    __device__ __forceinline__ bool next(int i, Unit& u) const { return next_(i, u); }
    __device__ __forceinline__ void rows(const Unit& u, int R0, unsigned (&off)[4]) const {
#pragma unroll
        for (int j = 0; j < 4; ++j) { const int r = R0 + 64 * j; int aid = 0; if (r < u.nvalid) aid = list[u.lbase + r]; off[j] = (unsigned)(aid >> 2) * (unsigned)KB; }
    }
};
struct MoeDnOrder : MoeOrder {
    static constexpr bool GATHER = false;
    __device__ __forceinline__ bool next(int i, Unit& u) const { return next_(i, u); }
    __device__ __forceinline__ void rows(const Unit&, int R0, unsigned (&off)[4]) const {
#pragma unroll
        for (int j = 0; j < 4; ++j) off[j] = (unsigned)((R0 + 64 * j) * KB);
    }
};

struct EpiBf16 {
    static constexpr bool PERM = true;
    bf16_t* O; int ldc;
    __device__ __forceinline__ void operator()(const f32x4 (&acc)[2][2][4][2], const Unit& u, int wr, int wc, int fr, int fq) const {
        const int row0 = u.pm * BM + wr * 64 + fr, col0 = u.pn * BM + wc * 32 + 8 * fq;
#pragma unroll
        for (int ai = 0; ai < 2; ++ai)
#pragma unroll
            for (int m = 0; m < 4; ++m) { bf16_t* rowp = O + (size_t)(row0 + ai * HALF + m * 16) * ldc + col0;
#pragma unroll
                for (int bj = 0; bj < 2; ++bj) { const f32x4 v0 = acc[ai][bj][m][0], v1 = acc[ai][bj][m][1];
                    u32x4 w; w.x = cvt_pk_bf16(v0[0], v0[1]); w.y = cvt_pk_bf16(v0[2], v0[3]); w.z = cvt_pk_bf16(v1[0], v1[1]); w.w = cvt_pk_bf16(v1[2], v1[3]);
                    *(u32x4*)(rowp + bj * HALF) = w; } }
    }
};
struct EpiH1 {
    static constexpr bool PERM = true;
    const bf16_t* xb; bf16_t* H1;
    __device__ __forceinline__ void operator()(const f32x4 (&acc)[2][2][4][2], const Unit& u, int wr, int wc, int fr, int fq) const {
        const int row0 = u.pm * BM + wr * 64 + fr, col0 = u.pn * BM + wc * 32 + 8 * fq;
#pragma unroll
        for (int ai = 0; ai < 2; ++ai)
#pragma unroll
            for (int m = 0; m < 4; ++m) { const size_t off = (size_t)(row0 + ai * HALF + m * 16) * D + col0;
#pragma unroll
                for (int bj = 0; bj < 2; ++bj) { const u32x4 xw = *(const u32x4*)(xb + off + bj * HALF); const f32x4 v0 = acc[ai][bj][m][0], v1 = acc[ai][bj][m][1];
                    u32x4 w; w.x = cvt_pk_bf16(bf_lo(xw.x) * ALPHA + v0[0], bf_hi(xw.x) * ALPHA + v0[1]); w.y = cvt_pk_bf16(bf_lo(xw.y) * ALPHA + v0[2], bf_hi(xw.y) * ALPHA + v0[3]);
                    w.z = cvt_pk_bf16(bf_lo(xw.z) * ALPHA + v1[0], bf_hi(xw.z) * ALPHA + v1[1]); w.w = cvt_pk_bf16(bf_lo(xw.w) * ALPHA + v1[2], bf_hi(xw.w) * ALPHA + v1[3]);
                    *(u32x4*)(H1 + off + bj * HALF) = w; }
                asm volatile("" ::: "memory"); }
    }
};
struct EpiGU {
    static constexpr bool PERM = true;
    unsigned char* H; const float* bgu;
    __device__ __forceinline__ void operator()(const f32x4 (&acc)[2][2][4][2], const Unit& u, int wr, int wc, int fr, int fq) const {
        const int row0 = u.pm * BM + wr * 64 + fr, cc = u.pn * HALF + wc * 32 + 8 * fq;
        const float* bp = bgu + (size_t)u.e * (2 * FF) + cc;
        f32x4 bg[2], bu[2];
#pragma unroll
        for (int n = 0; n < 2; ++n) { bg[n] = *(const f32x4*)(bp + 4 * n); bu[n] = *(const f32x4*)(bp + FF + 4 * n); }
#pragma unroll
        for (int ai = 0; ai < 2; ++ai)
#pragma unroll
            for (int m = 0; m < 4; ++m) { unsigned char* rowp = H + (size_t)(row0 + ai * HALF + m * 16) * FF + cc; float h[8];
#pragma unroll
                for (int n = 0; n < 2; ++n)
#pragma unroll
                    for (int i = 0; i < 4; i += 2) {
                        f32x2 g = (f32x2){acc[ai][0][m][n][i], acc[ai][0][m][n][i + 1]} + (f32x2){bg[n][i], bg[n][i + 1]};
                        g.x = __builtin_fminf(g.x, SW_LIMIT); g.y = __builtin_fminf(g.y, SW_LIMIT);
                        const f32x2 t = g * (-SW_ALPHA * 1.4426950408889634f);
                        f32x2 e; e.x = __builtin_amdgcn_exp2f(t.x); e.y = __builtin_amdgcn_exp2f(t.y);
                        const f32x2 d = e + 1.0f;
                        f32x2 sg; sg.x = __builtin_amdgcn_rcpf(d.x); sg.y = __builtin_amdgcn_rcpf(d.y);
                        f32x2 up = (f32x2){acc[ai][1][m][n][i], acc[ai][1][m][n][i + 1]} + (f32x2){bu[n][i], bu[n][i + 1]};
                        up.x = __builtin_amdgcn_fmed3f(up.x, -SW_LIMIT, SW_LIMIT); up.y = __builtin_amdgcn_fmed3f(up.y, -SW_LIMIT, SW_LIMIT);
                        const f32x2 hv = (up * HID_MUL + HID_MUL) * (g * sg);
                        h[4 * n + i] = hv.x; h[4 * n + i + 1] = hv.y; }
                u32x2 w; w.x = cvt4_fp8(h[0], h[1], h[2], h[3]); w.y = cvt4_fp8(h[4], h[5], h[6], h[7]);
                *(u32x2*)rowp = w; }
    }
};
struct EpiDown {
    static constexpr bool PERM = true;
    unsigned char* Y; const float* bdn; const int* list;
    __device__ __forceinline__ void operator()(const f32x4 (&acc)[2][2][4][2], const Unit& u, int wr, int wc, int fr, int fq) const {
        const int col0 = u.pn * BM + wc * 32 + 8 * fq;
        const float* bp = bdn + (size_t)u.e * D + col0;
        f32x4 bv[2][2];
#pragma unroll
        for (int bj = 0; bj < 2; ++bj)
#pragma unroll
            for (int n = 0; n < 2; ++n) bv[bj][n] = *(const f32x4*)(bp + bj * HALF + 4 * n);
        int aids[2][4];
#pragma unroll
        for (int ai = 0; ai < 2; ++ai)
#pragma unroll
            for (int m = 0; m < 4; ++m) { const int r = ai * HALF + wr * 64 + m * 16 + fr; aids[ai][m] = list[u.lbase + (r < u.nvalid ? r : u.nvalid - 1)]; }
#pragma unroll
        for (int ai = 0; ai < 2; ++ai)
#pragma unroll
            for (int m = 0; m < 4; ++m) { const int r = ai * HALF + wr * 64 + m * 16 + fr;
                if (r < u.nvalid) { const int aid = aids[ai][m]; unsigned char* rowp = Y + (size_t)aid * D + col0;
#pragma unroll
                    for (int bj = 0; bj < 2; ++bj) { const f32x4 v0 = (acc[ai][bj][m][0] + bv[bj][0]) * Y_MUL, v1 = (acc[ai][bj][m][1] + bv[bj][1]) * Y_MUL;
                        u32x2 w; w.x = cvt4_fp8(v0[0], v0[1], v0[2], v0[3]); w.y = cvt4_fp8(v1[0], v1[1], v1[2], v1[3]);
                        *(u32x2*)(rowp + bj * HALF) = w; } } }
    }
};
struct EpiGate {
    static constexpr bool PERM = true;
    const bf16_t* x2b; const bf16_t* ple; const float* bg; bf16_t* H3;
    __device__ __forceinline__ void operator()(const f32x4 (&acc)[2][2][4][2], const Unit& u, int wr, int wc, int fr, int fq) const {
        const int row0 = u.pm * BM + wr * 64 + fr, col0 = u.pn * BM + wc * 32 + 8 * fq;
        f32x4 bv[2][2];
#pragma unroll
        for (int bj = 0; bj < 2; ++bj)
#pragma unroll
            for (int n = 0; n < 2; ++n) bv[bj][n] = *(const f32x4*)(bg + col0 + bj * HALF + 4 * n);
#pragma unroll
        for (int ai = 0; ai < 2; ++ai)
#pragma unroll
            for (int m = 0; m < 4; ++m) { const size_t off = (size_t)(row0 + ai * HALF + m * 16) * D + col0;
#pragma unroll
                for (int bj = 0; bj < 2; ++bj) { const u32x4 xw = *(const u32x4*)(x2b + off + bj * HALF), pw = *(const u32x4*)(ple + off + bj * HALF);
                    const float xs[8] = {bf_lo(xw.x), bf_hi(xw.x), bf_lo(xw.y), bf_hi(xw.y), bf_lo(xw.z), bf_hi(xw.z), bf_lo(xw.w), bf_hi(xw.w)};
                    const float ps[8] = {bf_lo(pw.x), bf_hi(pw.x), bf_lo(pw.y), bf_hi(pw.y), bf_lo(pw.z), bf_hi(pw.z), bf_lo(pw.w), bf_hi(pw.w)};
                    float r[8];
#pragma unroll
                    for (int n = 0; n < 2; ++n)
#pragma unroll
                        for (int i = 0; i < 4; ++i) { const float z = acc[ai][bj][m][n][i] + bv[bj][n][i]; const float sg = __builtin_amdgcn_rcpf(1.0f + __builtin_amdgcn_exp2f(z * -1.4426950408889634f)); r[4 * n + i] = xs[4 * n + i] * ALPHA + sg * ps[4 * n + i]; }
                    u32x4 w; w.x = cvt_pk_bf16(r[0], r[1]); w.y = cvt_pk_bf16(r[2], r[3]); w.z = cvt_pk_bf16(r[4], r[5]); w.w = cvt_pk_bf16(r[6], r[7]);
                    *(u32x4*)(H3 + off + bj * HALF) = w; }
                asm volatile("" ::: "memory"); }
    }
};

template <class Epi, class Sched, bool FP8 = false>
__device__ __forceinline__ void gemm_phase(LAS unsigned char* lds, const int KB, const Sched& S, const Epi& E, const int scl_w = 0x7f7f7f7f, const int scl_x = 0x7f7f7f7f) {
    const int tid = threadIdx.x, wid = __builtin_amdgcn_readfirstlane(tid >> 6), lane = tid & 63, wr = wid >> 2, wc = wid & 3, fr = lane & 15, fq = lane >> 4;
    const int nt = KB / 128;
    int R0, C0; stage_rc(tid * 16, R0, C0);
    unsigned voffB[2];
#pragma unroll
    for (int i = 0; i < 2; ++i) { const int R = R0 + 64 * i; const int Rb = Epi::PERM ? ((R & ~31) + perm32(R & 31)) : R; voffB[i] = (unsigned)(Rb * KB + C0 * 2); }
    const unsigned coff = (unsigned)C0 * 2u;
    const size_t kstep = (size_t)(BK * 2);
    const size_t hstep = (size_t)HALF * KB;
    const unsigned ldsw = (unsigned)wid * 1024u;
    const int aoff = lds_byte(wr * 64 + fr, fq * 8), boff = lds_byte(wc * 32 + fr, fq * 8);
#define PG8_SA(b, h) (((b) * 2 + (h)) * HTB)
#define PG8_SB(b, h) ((4 + (b) * 2 + (h)) * HTB)
#define PG8_STAGE_B(bufoff, gbase) do { _Pragma("unroll") for (int _i = 0; _i < 2; ++_i) \
        __builtin_amdgcn_global_load_lds((const unsigned*)((const char*)(gbase) + voffB[_i]), (LAS unsigned*)(lds + (bufoff) + ldsw + _i * 8192), 16, 0, 0); } while (0)
#define PG8_STAGE_A(bufoff, gbase, off, h) do { _Pragma("unroll") for (int _i = 0; _i < 2; ++_i) \
        __builtin_amdgcn_global_load_lds((const unsigned*)((const char*)(gbase) + (off)[2 * (h) + _i]), (LAS unsigned*)(lds + (bufoff) + ldsw + _i * 8192), 16, 0, 0); } while (0)
#define PG8_LDA(dst, b, h) do { _Pragma("unroll") for (int m = 0; m < 4; ++m) { const i32x4 _l = *(const LAS i32x4*)(lds + PG8_SA(b, h) + aoff + m * 2048), _h = *(const LAS i32x4*)(lds + PG8_SA(b, h) + aoff + m * 2048 + 1024); \
        dst[m] = __builtin_shufflevector(_l, _h, 0, 1, 2, 3, 4, 5, 6, 7); } } while (0)
#define PG8_LDB(dst, b, h) do { _Pragma("unroll") for (int n = 0; n < 2; ++n) { const i32x4 _l = *(const LAS i32x4*)(lds + PG8_SB(b, h) + boff + n * 2048), _h = *(const LAS i32x4*)(lds + PG8_SB(b, h) + boff + n * 2048 + 1024); \
        dst[n] = __builtin_shufflevector(_l, _h, 0, 1, 2, 3, 4, 5, 6, 7); } } while (0)
#define PG8_MMA(ai, bj, At, Bt) do { __builtin_amdgcn_s_setprio(1); _Pragma("unroll") for (int m = 0; m < 4; ++m) _Pragma("unroll") for (int n = 0; n < 2; ++n) { \
        if constexpr (FP8) { asm volatile("v_mfma_scale_f32_16x16x128_f8f6f4 %0, %1, %2, %0, %3, %4 op_sel_hi:[0,0,0]" : "+v"(acc[ai][bj][m][n]) : "v"(Bt[n]), "v"(At[m]), "v"(scl_w), "v"(scl_x)); } \
        else { acc[ai][bj][m][n] = __builtin_amdgcn_mfma_f32_16x16x32_bf16(__builtin_bit_cast(bf16x8, __builtin_shufflevector(Bt[n], Bt[n], 0, 1, 2, 3)), __builtin_bit_cast(bf16x8, __builtin_shufflevector(At[m], At[m], 0, 1, 2, 3)), acc[ai][bj][m][n], 0, 0, 0); \
               acc[ai][bj][m][n] = __builtin_amdgcn_mfma_f32_16x16x32_bf16(__builtin_bit_cast(bf16x8, __builtin_shufflevector(Bt[n], Bt[n], 4, 5, 6, 7)), __builtin_bit_cast(bf16x8, __builtin_shufflevector(At[m], At[m], 4, 5, 6, 7)), acc[ai][bj][m][n], 0, 0, 0); } } __builtin_amdgcn_s_setprio(0); } while (0)
#define PG8_WAIT_V(n) asm volatile("s_waitcnt vmcnt(" #n ")" ::: "memory")
#define PG8_WAIT_L(n) asm volatile("s_waitcnt lgkmcnt(" #n ")" ::: "memory")
#define PG8_BAR __builtin_amdgcn_s_barrier()
#define PG8_SCHED __builtin_amdgcn_sched_barrier(0)
#define PG8_PIN4(o) asm volatile("" : "+v"((o)[0]), "+v"((o)[1]), "+v"((o)[2]), "+v"((o)[3]))
    Unit cur, nxt, nn; int ui = 0;
    if (!S.next(0, cur)) return;
    bool has_next = S.next(1, nxt);
    unsigned offc[4], offn[4], offnn[4];
    S.rows(cur, R0, offc);
    if (has_next) S.rows(nxt, R0, offn); else { _Pragma("unroll") for (int j = 0; j < 4; ++j) offn[j] = offc[j]; }
#pragma unroll
    for (int j = 0; j < 4; ++j) { offc[j] += coff; if (has_next) offn[j] += coff; else offn[j] = offc[j]; }
    if constexpr (Sched::GATHER) { PG8_PIN4(offc); PG8_PIN4(offn); }
    f32x4 acc[2][2][4][2];
#pragma unroll
    for (int a = 0; a < 2; ++a)
#pragma unroll
        for (int b = 0; b < 2; ++b)
#pragma unroll
            for (int m = 0; m < 4; ++m)
#pragma unroll
                for (int n = 0; n < 2; ++n) acc[a][b][m][n] = (f32x4){0.f, 0.f, 0.f, 0.f};
    i32x8 At[4], B0[2], B1[2];
    const char* cA = cur.A; const char* cB = cur.B;
    PG8_STAGE_B(PG8_SB(0, 0), cB); PG8_STAGE_B(PG8_SB(0, 1), cB + hstep); PG8_STAGE_A(PG8_SA(0, 0), cA, offc, 0); PG8_STAGE_A(PG8_SA(0, 1), cA, offc, 1);
    if (wr == 1) PG8_BAR;
    PG8_WAIT_V(2); PG8_BAR;
    PG8_STAGE_B(PG8_SB(1, 0), cB + kstep); PG8_STAGE_A(PG8_SA(1, 0), cA + kstep, offc, 0); PG8_STAGE_B(PG8_SB(1, 1), cB + hstep + kstep);
    PG8_WAIT_V(6); PG8_BAR;
    for (;;) {
        const char* nA = has_next ? nxt.A : cA; const char* nB = has_next ? nxt.B : cB;
#pragma nounroll
        for (int t = 0; t < nt; t += 2) {
            const bool last = (t == nt - 2);
            const char* a1 = cA + (size_t)(t + 1) * kstep;
            const char* a2 = last ? nA : cA + (size_t)(t + 2) * kstep; const char* b2 = last ? nB : cB + (size_t)(t + 2) * kstep;
            const char* a3 = a2 + kstep; const char* b3 = b2 + kstep;
            unsigned o2[4];
#pragma unroll
            for (int j = 0; j < 4; ++j) o2[j] = Sched::GATHER ? (last ? offn[j] : offc[j]) : offc[j];
            PG8_LDB(B0, 0, 0); PG8_LDB(B1, 0, 1); PG8_SCHED; PG8_LDA(At, 0, 0); PG8_STAGE_A(PG8_SA(1, 1), a1, offc, 1);
            PG8_WAIT_V(8); PG8_WAIT_L(0); PG8_BAR; PG8_MMA(0, 0, At, B0); PG8_MMA(0, 1, At, B1); PG8_BAR; PG8_SCHED;
            PG8_LDA(At, 0, 1); PG8_STAGE_B(PG8_SB(0, 0), b2); PG8_STAGE_B(PG8_SB(0, 1), b2 + hstep); PG8_STAGE_A(PG8_SA(0, 0), a2, o2, 0);
            PG8_WAIT_V(8); PG8_WAIT_L(0); PG8_BAR; PG8_MMA(1, 0, At, B0); PG8_MMA(1, 1, At, B1); PG8_BAR; PG8_SCHED;
            PG8_LDB(B0, 1, 0); PG8_LDB(B1, 1, 1); PG8_SCHED; PG8_LDA(At, 1, 0); PG8_STAGE_A(PG8_SA(0, 1), a2, o2, 1);
            PG8_WAIT_V(8); PG8_WAIT_L(0); PG8_BAR; PG8_MMA(0, 0, At, B0); PG8_MMA(0, 1, At, B1); PG8_BAR; PG8_SCHED;
            PG8_LDA(At, 1, 1); PG8_STAGE_B(PG8_SB(1, 0), b3); PG8_STAGE_B(PG8_SB(1, 1), b3 + hstep); PG8_STAGE_A(PG8_SA(1, 0), a3, o2, 0);
            PG8_WAIT_V(8); PG8_WAIT_L(0); PG8_BAR; PG8_MMA(1, 0, At, B0); PG8_MMA(1, 1, At, B1); PG8_BAR; PG8_SCHED;
        }
        if constexpr (FP8) asm volatile("s_nop 15\n\ts_nop 15" ::: "memory");
        if (wr == 0) PG8_BAR;
        bool has2 = false;
        if (has_next) { has2 = S.next(ui + 2, nn); if (has2) { S.rows(nn, R0, offnn); } }
        { int fr_e = fr, fq_e = fq; asm volatile("" : "+v"(fr_e), "+v"(fq_e));
          E(acc, cur, wr, wc, fr_e, fq_e); }
        if (!has_next) break;
#pragma unroll
        for (int a = 0; a < 2; ++a)
#pragma unroll
            for (int b = 0; b < 2; ++b)
#pragma unroll
                for (int m = 0; m < 4; ++m)
#pragma unroll
                    for (int n = 0; n < 2; ++n) acc[a][b][m][n] = (f32x4){0.f, 0.f, 0.f, 0.f};
        cur = nxt; cA = nA; cB = nB; ++ui;
#pragma unroll
        for (int j = 0; j < 4; ++j) { offc[j] = offn[j]; if (has2) offn[j] = offnn[j] + coff; }
        if (has2) nxt = nn;
        has_next = has2;
        if constexpr (Sched::GATHER) { PG8_PIN4(offn); }
        if (wr == 1) PG8_BAR;
    }
    PG8_WAIT_V(0);
    PG8_BAR;
#undef PG8_SA
#undef PG8_SB
#undef PG8_STAGE_A
#undef PG8_STAGE_B
#undef PG8_LDA
#undef PG8_LDB
#undef PG8_MMA
#undef PG8_WAIT_V
#undef PG8_WAIT_L
#undef PG8_BAR
#undef PG8_SCHED
#undef PG8_PIN4
}
}

#define XB_TMO      128
#define XB_XCNT(j)  (256  + 64 * (j))
#define XB_XSUB(j)  (1280 + 64 * (j))
#define XB_XGEN(j)  (2304 + 64 * (j))
#define XB_TOP      3328
#define XB_TOPGEN   3392
#define XCD_BAR_WORDS 3456
#define XB_SPIN_CAP (1u << 18)
__device__ __forceinline__ unsigned xb_ld(unsigned* p)              { return __hip_atomic_load(p, __ATOMIC_RELAXED, __HIP_MEMORY_SCOPE_AGENT); }
__device__ __forceinline__ unsigned xb_add(unsigned* p, unsigned v) { return __hip_atomic_fetch_add(p, v, __ATOMIC_RELAXED, __HIP_MEMORY_SCOPE_AGENT); }
__device__ __forceinline__ unsigned xb_xcc_id() { return (unsigned)__builtin_amdgcn_s_getreg((3 << 11) | 20) & 0xFu; }
#define XB_SPIN(cond, bar) do { unsigned _sp = 0; while (cond) { __builtin_amdgcn_s_sleep(1); \
    if ((++_sp & 255u) == 0u) { if (xb_ld(&(bar)[XB_TMO])) break; if (_sp > XB_SPIN_CAP) { atomicAdd(&(bar)[XB_TMO], 1u); break; } } } } while (0)
struct XcdBarrier { unsigned* bar; unsigned x; volatile LAS unsigned* st; };
__device__ __forceinline__ XcdBarrier xcd_barrier_post(unsigned* bar, volatile LAS unsigned* st) {
    XcdBarrier b; b.bar = bar; b.x = xb_xcc_id(); b.st = st;
    if (threadIdx.x == 0) (void)xb_add(&bar[XB_XCNT(b.x)], 1u);
    return b;
}
__device__ __forceinline__ void xcd_barrier_complete(unsigned* bar, unsigned x, unsigned& nloc, unsigned& nx) {
    const unsigned G = gridDim.x * gridDim.y * gridDim.z;
    unsigned sum, cnt, mine, sp = 0u;
    for (;;) {
        sum = 0u; cnt = 0u; mine = 0u;
#pragma unroll
        for (unsigned j = 0; j < 16; ++j) { const unsigned c = xb_ld(&bar[XB_XCNT(j)]); sum += c; cnt += (c > 0u) ? 1u : 0u; mine = (j == x) ? c : mine; }
        if (sum == G) break;
        __builtin_amdgcn_s_sleep(1);
        if ((++sp & 255u) == 0u) { if (xb_ld(&bar[XB_TMO])) break; if (sp > XB_SPIN_CAP) { atomicAdd(&bar[XB_TMO], 1u); break; } }
    }
    nloc = mine > 0u ? mine : 1u; nx = cnt > 0u ? cnt : 1u;
}
__device__ __forceinline__ void xcd_barrier(const XcdBarrier& b) {
    asm volatile("s_waitcnt vmcnt(0)" ::: "memory");
    __syncthreads();
    if (threadIdx.x == 0) {
        unsigned* bar = b.bar;
        __builtin_amdgcn_s_waitcnt(0);
        unsigned nloc = b.st[0], nx = b.st[1];
        if (nloc == 0u) { xcd_barrier_complete(bar, b.x, nloc, nx); b.st[0] = nloc; b.st[1] = nx; }
        const unsigned old = xb_add(&bar[XB_XSUB(b.x)], 1u);
        const unsigned gen = old / nloc;
        if (old + 1u == (gen + 1u) * nloc) {
            __builtin_amdgcn_fence(__ATOMIC_RELEASE, "agent");
            asm volatile("s_waitcnt vmcnt(0)" ::: "memory");
            const unsigned og = xb_add(&bar[XB_TOP], 1u);
            const unsigned tg = og / nx;
            if (og + 1u == (tg + 1u) * nx) xb_add(&bar[XB_TOPGEN], 1u);
            else XB_SPIN(xb_ld(&bar[XB_TOPGEN]) == tg, bar);
            __builtin_amdgcn_fence(__ATOMIC_ACQUIRE, "agent");
            xb_add(&bar[XB_XGEN(b.x)], 1u);
            asm volatile("s_waitcnt vmcnt(0)" ::: "memory");
        } else {
            XB_SPIN(xb_ld(&bar[XB_XGEN(b.x)]) == gen, bar);
            __builtin_amdgcn_fence(__ATOMIC_ACQUIRE, "agent");
            asm volatile("s_waitcnt vmcnt(0)" ::: "memory");
        }
    }
    __syncthreads();
}

struct Args {
    const float* x; const float* p; const float* w_in; const float* pool_mix; const float* pool_scale; const float* conv_w; const float* w_out;
    const float* ln1_g; const float* ln1_b; const float* router_w; const float* router_b; const float* w_gu; const float* b_gu; const float* w_dn; const float* b_dn;
    const float* ln2_g; const float* ln2_b; const float* ple_proj; const float* ple_gate_w; const float* ple_gate_b; const float* ln3_g; const float* ln3_b;
    float* out; unsigned char* ws; int ph_lo, ph_hi;
};
struct Frame { LAS unsigned char* lds; int tid, lane, wave, vcu, G; };

__device__ __forceinline__ void fold_item(const Args& a, bf16_t* W2T, LAS float* scr, int item, int lane) {
    const int g = item >> 8, cb = (item >> 4) & 15, nb = item & 15, c0 = cb * 8, n = nb * 64 + lane;
#pragma unroll
    for (int i = 0; i < 16; ++i) { const int idx = i * 64 + lane, c = idx >> 7, d = idx & 127; scr[d * 8 + c] = a.pool_mix[(size_t)(g * 128 + c0 + c) * 128 + d]; }
    LDS_WAIT(); asm volatile("" ::: "memory");
    float acc[8];
#pragma unroll
    for (int c = 0; c < 8; ++c) acc[c] = 0.f;
#pragma unroll 4
    for (int d = 0; d < 128; ++d) {
        const float wv = a.w_out[(size_t)(g * 128 + d) * D + n] * a.pool_scale[g * 128 + d];
        const f32x4 p0 = *(const LAS f32x4*)(scr + d * 8), p1 = *(const LAS f32x4*)(scr + d * 8 + 4);
        acc[0] += p0[0] * wv; acc[1] += p0[1] * wv; acc[2] += p0[2] * wv; acc[3] += p0[3] * wv;
        acc[4] += p1[0] * wv; acc[5] += p1[1] * wv; acc[6] += p1[2] * wv; acc[7] += p1[3] * wv;
    }
    u32x4 o; o.x = cvt_pk_bf16(acc[0], acc[1]); o.y = cvt_pk_bf16(acc[2], acc[3]); o.z = cvt_pk_bf16(acc[4], acc[5]); o.w = cvt_pk_bf16(acc[6], acc[7]);
    *(u32x4*)(W2T + (size_t)n * D + g * 128 + c0) = o;
    LDS_WAIT(); asm volatile("" ::: "memory");
}
struct TrDesc { const float* src; unsigned char* dst; int ld_src, ld_dst  , fp8; float mul; };
__device__ __forceinline__ void tr_load(const TrDesc& d, int lane, f32x4 (&v)[8]) {
    const int kr = lane >> 3, nq = lane & 7;
#pragma unroll
    for (int r = 0; r < 8; ++r) v[r] = *(const f32x4*)(d.src + (size_t)(8 * r + kr) * d.ld_src + 4 * nq);
}
__device__ __forceinline__ void tr_finish(const TrDesc& d, const f32x4 (&v)[8], LAS float* scr, int lane) {
    const int kr = lane >> 3, nq = lane & 7;
#pragma unroll
    for (int r = 0; r < 8; ++r)
#pragma unroll
        for (int q = 0; q < 4; ++q) scr[(8 * r + kr) * 33 + 4 * nq + q] = v[r][q] * d.mul;
    LDS_WAIT(); asm volatile("" ::: "memory");
    const int c = lane & 7;
    if (d.fp8) {
#pragma unroll
        for (int j = 0; j < 4; ++j) { const int n = (lane >> 3) + 8 * j; const LAS float* s = scr + (8 * c) * 33 + n;
            u32x2 o; o.x = cvt4_fp8(s[0 * 33], s[1 * 33], s[2 * 33], s[3 * 33]); o.y = cvt4_fp8(s[4 * 33], s[5 * 33], s[6 * 33], s[7 * 33]);
            *(u32x2*)(d.dst + (size_t)n * d.ld_dst + 8 * c) = o; }
    } else {
#pragma unroll
        for (int j = 0; j < 4; ++j) { const int n = (lane >> 3) + 8 * j; const LAS float* s = scr + (8 * c) * 33 + n;
            u32x4 o; o.x = cvt_pk_bf16(s[0 * 33], s[1 * 33]); o.y = cvt_pk_bf16(s[2 * 33], s[3 * 33]); o.z = cvt_pk_bf16(s[4 * 33], s[5 * 33]); o.w = cvt_pk_bf16(s[6 * 33], s[7 * 33]);
            *(u32x4*)(d.dst + (size_t)n * d.ld_dst + 16 * c) = o; }
    }
    LDS_WAIT(); asm volatile("" ::: "memory");
}
constexpr int I_IN = 16 * 64, I_OUT = 8 * 32, I_G = 16 * 32, I_P = 4 * 32, I_GU = NE * 16 * 64, I_DN = NE * 16 * 32, N_TR = I_IN + I_OUT + I_G + I_P + I_GU + I_DN, I_FOLD = 1024;
__device__ __forceinline__ TrDesc tr_decode(const Args& a, int r) {
    unsigned char* ws = a.ws; TrDesc d; d.fp8 = 0; d.mul = 1.0f;
    if (r < I_IN) { const int kb = r >> 6, nb = r & 63; d.src = a.w_in + (size_t)(64 * kb) * DIN + 32 * nb; d.ld_src = DIN; d.dst = ws + WS_WIN + ((size_t)(32 * nb) * D + 64 * kb) * 2; d.ld_dst = D * 2; return d; } r -= I_IN;
    if (r < I_OUT) { const int kb = r >> 5, nb = r & 31; d.src = a.w_out + (size_t)(DPOOL + 64 * kb) * D + 32 * nb; d.ld_src = D; d.dst = ws + WS_W2 + ((size_t)(32 * nb) * D + DPOOL + 64 * kb) * 2; d.ld_dst = D * 2; return d; } r -= I_OUT;
    if (r < I_G) { const int kb = r >> 5, nb = r & 31; d.src = a.ple_gate_w + (size_t)(64 * kb) * D + 32 * nb; d.ld_src = D; d.dst = ws + WS_WG + ((size_t)(32 * nb) * D + 64 * kb) * 2; d.ld_dst = D * 2; return d; } r -= I_G;
    if (r < I_P) { const int kb = r >> 5, nb = r & 31; d.src = a.ple_proj + (size_t)(64 * kb) * D + 32 * nb; d.ld_src = D; d.dst = ws + WS_WP + ((size_t)(32 * nb) * PLE + 64 * kb) * 2; d.ld_dst = PLE * 2; return d; } r -= I_P;
    if (r < I_GU) { const int e = r >> 10, q = r & 1023, kb = q >> 6, nb = q & 63, n0 = 32 * nb;
        const int h = n0 >> 10, j = n0 & 1023, drow = (j >> 7) * 256 + h * 128 + (j & 127);
        d.src = a.w_gu + ((size_t)e * D + 64 * kb) * (2 * FF) + n0; d.ld_src = 2 * FF; d.dst = ws + WS_WGU + ((size_t)e * (2 * FF) + drow) * D + 64 * kb; d.ld_dst = D; d.fp8 = 1; d.mul = WGU_MUL; return d; } r -= I_GU;
    { const int e = r >> 9, q = r & 511, kb = q >> 5, nb = q & 31;
        d.src = a.w_dn + ((size_t)e * FF + 64 * kb) * D + 32 * nb; d.ld_src = D; d.dst = ws + WS_WDN + ((size_t)e * D + 32 * nb) * FF + 64 * kb; d.ld_dst = FF; d.fp8 = 1; d.mul = WDN_MUL; return d; }
}
template <int NEL8>
__device__ __forceinline__ void cvt_stream(const float* src, bf16_t* dst, size_t n8, size_t gt, size_t NT) {
    const f32x4* s = (const f32x4*)src; u32x4* d = (u32x4*)dst;
    for (size_t i = gt; i < n8; i += 4 * NT) { f32x4 v[4][2];
#pragma unroll
        for (int u = 0; u < 4; ++u) { const size_t ii = i + u * NT; if (ii < n8) { v[u][0] = s[2 * ii]; v[u][1] = s[2 * ii + 1]; } }
#pragma unroll
        for (int u = 0; u < 4; ++u) { const size_t ii = i + u * NT; if (ii < n8) { u32x4 o; o.x = cvt_pk_bf16(v[u][0][0], v[u][0][1]); o.y = cvt_pk_bf16(v[u][0][2], v[u][0][3]); o.z = cvt_pk_bf16(v[u][1][0], v[u][1][1]); o.w = cvt_pk_bf16(v[u][1][2], v[u][1][3]); d[ii] = o; } } }
}
__device__ __forceinline__ void p0_prologue(const Frame& F, const Args& a) {
    unsigned char* ws = a.ws;
    LAS float* scr = (LAS float*)(F.lds + F.wave * 16384);
    const int gw = F.vcu * 8 + F.wave, NGW = F.G * 8;
    for (int it = gw; it < I_FOLD; it += NGW) fold_item(a, (bf16_t*)(ws + WS_W2), scr, it, F.lane);
    { int it = gw; f32x4 vc[8], vn[8]; TrDesc dc, dn;
      if (it < N_TR) { dc = tr_decode(a, it); tr_load(dc, F.lane, vc); }
      while (it < N_TR) { const int itn = it + NGW; const bool hn = itn < N_TR;
          if (hn) { dn = tr_decode(a, itn); tr_load(dn, F.lane, vn); }
          tr_finish(dc, vc, scr, F.lane);
          if (hn) { dc = dn;
#pragma unroll
              for (int r = 0; r < 8; ++r) vc[r] = vn[r]; }
          it = itn; } }
    const size_t gt = (size_t)F.vcu * 512 + F.tid, NT = (size_t)F.G * 512;
    cvt_stream<0>(a.x, (bf16_t*)(ws + WS_XB), (size_t)M * D / 8, gt, NT);
    cvt_stream<0>(a.p, (bf16_t*)(ws + WS_PB), (size_t)M * PLE / 8, gt, NT);
}

__device__ __forceinline__ void unpack8(const u32x4 w, float (&f)[8]) { f[0] = bf_lo(w.x); f[1] = bf_hi(w.x); f[2] = bf_lo(w.y); f[3] = bf_hi(w.y); f[4] = bf_lo(w.z); f[5] = bf_hi(w.z); f[6] = bf_lo(w.w); f[7] = bf_hi(w.w); }
template <int W>
__device__ __forceinline__ void pool_item(const bf16_t* proj, bf16_t* A2, int t0, int g, int lane) {
    const int cb = lane & 15, ts = lane >> 4, tb = t0 + 16 * ts, c = g * 128 + cb * 8, seq0 = tb & ~(SEQ - 1);
    u32x4 rows[15 + W];
#pragma unroll
    for (int i = 0; i < 15 + W; ++i) { const int tr = tb - (W - 1) + i; const int trc = tr < seq0 ? seq0 : tr; rows[i] = *(const u32x4*)(proj + (size_t)trc * DIN + c); }
#pragma unroll
    for (int i = 0; i < W - 1; ++i) { const int tr = tb - (W - 1) + i; if (tr < seq0) rows[i] = (u32x4){0u, 0u, 0u, 0u}; }
    float S[8];
#pragma unroll
    for (int q = 0; q < 8; ++q) S[q] = 0.f;
#pragma unroll
    for (int i = 0; i < W - 1; ++i) { float f[8]; unpack8(rows[i], f);
#pragma unroll
        for (int q = 0; q < 8; ++q) S[q] += f[q]; }
#pragma unroll
    for (int j = 0; j < 16; ++j) { float cur[8], old[8]; unpack8(rows[j + W - 1], cur); unpack8(rows[j], old);
        const int sp1 = tb + j - seq0 + 1; const float inv = sp1 >= W ? (1.0f / (float)W) : (1.0f / (float)sp1); float o[8];
#pragma unroll
        for (int q = 0; q < 8; ++q) { S[q] += cur[q]; o[q] = S[q] * inv - cur[q]; S[q] -= old[q]; }
        u32x4 w; w.x = cvt_pk_bf16(o[0], o[1]); w.y = cvt_pk_bf16(o[2], o[3]); w.z = cvt_pk_bf16(o[4], o[5]); w.w = cvt_pk_bf16(o[6], o[7]);
        *(u32x4*)(A2 + (size_t)(tb + j) * D + c) = w; }
}
__device__ __forceinline__ void conv_item(const bf16_t* proj, bf16_t* A2, const float (&cw)[3][8], int tb, int lane) {
    const int c = 8 * lane, seq0 = tb & ~(SEQ - 1);
    u32x4 rc[10], rv[10], rb[8];
#pragma unroll
    for (int i = 0; i < 10; ++i) { const int tr = tb - 2 + i; const int trc = tr < seq0 ? seq0 : tr; const bf16_t* rp = proj + (size_t)trc * DIN + c; rc[i] = *(const u32x4*)(rp + 1024); rv[i] = *(const u32x4*)(rp + 1536); }
#pragma unroll
    for (int j = 0; j < 8; ++j) rb[j] = *(const u32x4*)(proj + (size_t)(tb + j) * DIN + 512 + c);
    float u[3][8];
#pragma unroll
    for (int i = 0; i < 2; ++i) { float fc[8], fv[8]; unpack8(rc[i], fc); unpack8(rv[i], fv); const bool ok = (tb - 2 + i) >= seq0;
#pragma unroll
        for (int q = 0; q < 8; ++q) u[i][q] = ok ? fc[q] * fv[q] : 0.f; }
#pragma unroll
    for (int j = 0; j < 8; ++j) { float fc[8], fv[8], fb[8], y[8]; unpack8(rc[j + 2], fc); unpack8(rv[j + 2], fv); unpack8(rb[j], fb);
#pragma unroll
        for (int q = 0; q < 8; ++q) { u[2][q] = fc[q] * fv[q]; y[q] = fb[q] * (cw[0][q] * u[0][q] + cw[1][q] * u[1][q] + cw[2][q] * u[2][q]); u[0][q] = u[1][q]; u[1][q] = u[2][q]; }
        u32x4 w; w.x = cvt_pk_bf16(y[0], y[1]); w.y = cvt_pk_bf16(y[2], y[3]); w.z = cvt_pk_bf16(y[4], y[5]); w.w = cvt_pk_bf16(y[6], y[7]);
        *(u32x4*)(A2 + (size_t)(tb + j) * D + DPOOL + c) = w; }
}
__device__ __forceinline__ void p2_mixer(const Frame& F, const Args& a) {
    const bf16_t* proj = (const bf16_t*)(a.ws + WS_PROJ); bf16_t* A2 = (bf16_t*)(a.ws + WS_A2);
    const int gw = F.vcu * 8 + F.wave, NGW = F.G * 8;
    for (int it = gw; it < 4 * (M / 64); it += NGW) { const int g = it & 3, t0 = (it >> 2) * 64;
        if (g == 0) pool_item<2>(proj, A2, t0, 0, F.lane); else if (g == 1) pool_item<4>(proj, A2, t0, 1, F.lane); else if (g == 2) pool_item<8>(proj, A2, t0, 2, F.lane); else pool_item<16>(proj, A2, t0, 3, F.lane); }
    float cw[3][8];
#pragma unroll
    for (int k = 0; k < 3; ++k)
#pragma unroll
        for (int i = 0; i < 8; ++i) cw[k][i] = a.conv_w[k * DPOOL + 8 * F.lane + i];
    for (int it = gw; it < M / 8; it += NGW) conv_item(proj, A2, cw, it * 8, F.lane);
}

__device__ __forceinline__ void load_row16(const float* rp, int lane, float (&v)[16]) {
#pragma unroll
    for (int j = 0; j < 2; ++j) { const f32x4 a0 = *(const f32x4*)(rp + 8 * lane + 512 * j), a1 = *(const f32x4*)(rp + 8 * lane + 512 * j + 4);
#pragma unroll
        for (int i = 0; i < 4; ++i) { v[8 * j + i] = a0[i]; v[8 * j + 4 + i] = a1[i]; } }
}
__device__ __forceinline__ void store_row16(float* rp, int lane, const float (&v)[16]) {
#pragma unroll
    for (int j = 0; j < 2; ++j) { *(f32x4*)(rp + 8 * lane + 512 * j) = (f32x4){v[8 * j], v[8 * j + 1], v[8 * j + 2], v[8 * j + 3]}; *(f32x4*)(rp + 8 * lane + 512 * j + 4) = (f32x4){v[8 * j + 4], v[8 * j + 5], v[8 * j + 6], v[8 * j + 7]}; }
}
__device__ __forceinline__ void unpack_row16(const u32x4 (&w)[2], float (&v)[16]) {
#pragma unroll
    for (int j = 0; j < 2; ++j) { v[8 * j] = bf_lo(w[j].x); v[8 * j + 1] = bf_hi(w[j].x); v[8 * j + 2] = bf_lo(w[j].y); v[8 * j + 3] = bf_hi(w[j].y); v[8 * j + 4] = bf_lo(w[j].z); v[8 * j + 5] = bf_hi(w[j].z); v[8 * j + 6] = bf_lo(w[j].w); v[8 * j + 7] = bf_hi(w[j].w); }
}
__device__ __forceinline__ void load_row16_bfw(const bf16_t* rp, int lane, u32x4 (&w)[2]) { w[0] = *(const u32x4*)(rp + 8 * lane); w[1] = *(const u32x4*)(rp + 8 * lane + 512); }
__device__ __forceinline__ void store_row16_bf(bf16_t* rp, int lane, const float (&v)[16]) {
#pragma unroll
    for (int j = 0; j < 2; ++j) { u32x4 o; o.x = cvt_pk_bf16(v[8 * j], v[8 * j + 1]); o.y = cvt_pk_bf16(v[8 * j + 2], v[8 * j + 3]); o.z = cvt_pk_bf16(v[8 * j + 4], v[8 * j + 5]); o.w = cvt_pk_bf16(v[8 * j + 6], v[8 * j + 7]); *(u32x4*)(rp + 8 * lane + 512 * j) = o; }
}
__device__ __forceinline__ void ln_row16(float (&v)[16], const float (&g)[16], const float (&b)[16]) {
    float s = 0.f;
#pragma unroll
    for (int i = 0; i < 16; ++i) s += v[i];
    const float mean = wave_sum(s) * (1.0f / D); float q = 0.f;
#pragma unroll
    for (int i = 0; i < 16; ++i) { v[i] -= mean; q += v[i] * v[i]; }
    const float rstd = 1.0f / sqrtf(wave_sum(q) * (1.0f / D) + LN_EPS);
#pragma unroll
    for (int i = 0; i < 16; ++i) v[i] = v[i] * rstd * g[i] + b[i];
}

__device__ __forceinline__ void ln_rows2(float (&v)[2][16], const float (&g)[16], const float (&b)[16]) {
    float s0 = 0.f, s1 = 0.f;
#pragma unroll
    for (int i = 0; i < 16; ++i) { s0 += v[0][i]; s1 += v[1][i]; }
#pragma unroll
    for (int o = 1; o < 64; o <<= 1) { s0 += __shfl_xor(s0, o); s1 += __shfl_xor(s1, o); }
    const float m0 = s0 * (1.0f / D), m1 = s1 * (1.0f / D); float q0 = 0.f, q1 = 0.f;
#pragma unroll
    for (int i = 0; i < 16; ++i) { v[0][i] -= m0; v[1][i] -= m1; q0 += v[0][i] * v[0][i]; q1 += v[1][i] * v[1][i]; }
#pragma unroll
    for (int o = 1; o < 64; o <<= 1) { q0 += __shfl_xor(q0, o); q1 += __shfl_xor(q1, o); }
    const float r0 = 1.0f / sqrtf(q0 * (1.0f / D) + LN_EPS), r1 = 1.0f / sqrtf(q1 * (1.0f / D) + LN_EPS);
#pragma unroll
    for (int i = 0; i < 16; ++i) { v[0][i] = v[0][i] * r0 * g[i] + b[i]; v[1][i] = v[1][i] * r1 * g[i] + b[i]; }
}
constexpr int XPITCH = 2064;
constexpr int L_XHI = 0, L_XLO = 16 * XPITCH, L_PART = 2 * 16 * XPITCH  ;
__device__ __forceinline__ void p4_ln1_router(const Frame& F, const Args& a) {
    bf16_t* X1B = (bf16_t*)(a.ws + WS_XB1); unsigned char* X1F8 = a.ws + WS_X1F8; float* TG = (float*)(a.ws + WS_TG); int* LIST = (int*)(a.ws + WS_LIST);
    unsigned* gcnt = (unsigned*)(a.ws + WS_CTL) + CW_CNT;
    LAS unsigned* lhist = (LAS unsigned*)(F.lds + L_HIST); LAS unsigned* lbase = (LAS unsigned*)(F.lds + L_BASE); LAS unsigned* asg = (LAS unsigned*)(F.lds + L_ASG);
    const int lane = F.lane, w = F.wave, fr = lane & 15, fq = lane >> 4;
    if (F.tid < 32) lhist[F.tid] = 0u;
    float g[16], b[16];
    load_row16(a.ln1_g, lane, g); load_row16(a.ln1_b, lane, b);
    bf16x8 bhi[4][2], blo[4][2];
#pragma unroll
    for (int ks = 0; ks < 4; ++ks)
#pragma unroll
        for (int h = 0; h < 2; ++h) { unsigned hw[4], lw[4];
#pragma unroll
            for (int i2 = 0; i2 < 4; ++i2) { const int k = 128 * w + 32 * ks + 8 * fq + 2 * i2; const float v0 = a.router_w[(size_t)k * NE + 16 * h + fr], v1 = a.router_w[(size_t)(k + 1) * NE + 16 * h + fr];
                const unsigned hp = cvt_pk_bf16(v0, v1); const float r0 = v0 - bf_lo(hp), r1 = v1 - bf_hi(hp); hw[i2] = hp; lw[i2] = cvt_pk_bf16(r0, r1); }
            bhi[ks][h] = __builtin_bit_cast(bf16x8, (u32x4){hw[0], hw[1], hw[2], hw[3]}); blo[ks][h] = __builtin_bit_cast(bf16x8, (u32x4){lw[0], lw[1], lw[2], lw[3]}); }
    const float rbias = a.router_b[F.tid & 31];
    __syncthreads();
    int gl = 0;
    u32x4 vn[2][2];
#pragma unroll
    for (int rr = 0; rr < 2; ++rr) load_row16_bfw(X1B + (size_t)(F.vcu * 16 + 2 * w + rr) * D, lane, vn[rr]);
    for (int grp = F.vcu; grp < M / 16; grp += F.G, ++gl) {
        const int row0 = grp * 16;
        float v2[2][16];
#pragma unroll
        for (int rr = 0; rr < 2; ++rr) unpack_row16(vn[rr], v2[rr]);
        if (grp + F.G < M / 16) {
#pragma unroll
            for (int rr = 0; rr < 2; ++rr) load_row16_bfw(X1B + (size_t)((grp + F.G) * 16 + 2 * w + rr) * D, lane, vn[rr]); }
        ln_rows2(v2, g, b);
#pragma unroll
        for (int rr = 0; rr < 2; ++rr) { const int rl = 2 * w + rr; float (&v)[16] = v2[rr];
#pragma unroll
            for (int j = 0; j < 2; ++j) { unsigned hw[4], lw[4];
#pragma unroll
                for (int i2 = 0; i2 < 4; ++i2) { const float v0 = v[8 * j + 2 * i2], v1 = v[8 * j + 2 * i2 + 1]; const unsigned hp = cvt_pk_bf16(v0, v1); hw[i2] = hp; lw[i2] = cvt_pk_bf16(v0 - bf_lo(hp), v1 - bf_hi(hp)); }
                const u32x4 hv = {hw[0], hw[1], hw[2], hw[3]}, lv = {lw[0], lw[1], lw[2], lw[3]};
                *(u32x4*)(X1B + (size_t)(row0 + rl) * D + 8 * lane + 512 * j) = hv;
                { u32x2 f8; f8.x = cvt4_fp8(v[8 * j], v[8 * j + 1], v[8 * j + 2], v[8 * j + 3]); f8.y = cvt4_fp8(v[8 * j + 4], v[8 * j + 5], v[8 * j + 6], v[8 * j + 7]); *(u32x2*)(X1F8 + (size_t)(row0 + rl) * D + 8 * lane + 512 * j) = f8; }
                *(LAS u32x4*)(F.lds + L_XHI + rl * XPITCH + (8 * lane + 512 * j) * 2) = hv; *(LAS u32x4*)(F.lds + L_XLO + rl * XPITCH + (8 * lane + 512 * j) * 2) = lv; } }
        __syncthreads();
        f32x4 acc[2] = {(f32x4){0.f, 0.f, 0.f, 0.f}, (f32x4){0.f, 0.f, 0.f, 0.f}};
#pragma unroll
        for (int ks = 0; ks < 4; ++ks) { const int ko = (128 * w + 32 * ks + 8 * fq) * 2;
            const bf16x8 ahi = *(const LAS bf16x8*)(F.lds + L_XHI + fr * XPITCH + ko), alo = *(const LAS bf16x8*)(F.lds + L_XLO + fr * XPITCH + ko);
#pragma unroll
            for (int h = 0; h < 2; ++h) { acc[h] = __builtin_amdgcn_mfma_f32_16x16x32_bf16(bhi[ks][h], ahi, acc[h], 0, 0, 0); acc[h] = __builtin_amdgcn_mfma_f32_16x16x32_bf16(blo[ks][h], ahi, acc[h], 0, 0, 0);
                acc[h] = __builtin_amdgcn_mfma_f32_16x16x32_bf16(bhi[ks][h], alo, acc[h], 0, 0, 0); } }
#pragma unroll
        for (int h = 0; h < 2; ++h) *(LAS f32x4*)(F.lds + L_PART + ((w * 16 + fr) * 32 + 16 * h + 4 * fq) * 4) = acc[h];
        __syncthreads();
        { const int rl = F.tid >> 5, e = F.tid & 31; float v = rbias;
#pragma unroll
            for (int ww = 0; ww < 8; ++ww) v += *(const LAS float*)(F.lds + L_PART + ((ww * 16 + rl) * 32 + e) * 4);
            bool taken = false; float sv[4]; int si[4];
#pragma unroll
            for (int r = 0; r < 4; ++r) { float bv = taken ? -__builtin_inff() : v; int bi = e;
#pragma unroll
                for (int mk = 1; mk < 32; mk <<= 1) { const float ov = __shfl_xor(bv, mk); const int oi = __shfl_xor(bi, mk); if (ov > bv || (ov == bv && oi < bi)) { bv = ov; bi = oi; } }
                sv[r] = bv; si[r] = bi; if (bi == e) taken = true; }
            const float p1 = __expf(sv[1] - sv[0]), p2 = __expf(sv[2] - sv[0]), p3 = __expf(sv[3] - sv[0]); const float inv = 1.0f / (1.0f + p1 + p2 + p3);
            if (e < 4) { const float gk = (e == 0 ? 1.0f : e == 1 ? p1 : e == 2 ? p2 : p3) * inv; const int ek = e == 0 ? si[0] : e == 1 ? si[1] : e == 2 ? si[2] : si[3];
                TG[(size_t)(row0 + rl) * 4 + e] = gk;
                const unsigned rank = atomicAdd((unsigned*)(lhist + ek), 1u);
                asg[(gl * 16 + rl) * 4 + e] = ((unsigned)ek << 16) | rank; } }
    }
    __syncthreads();
    if (F.tid < 32) lbase[F.tid] = __hip_atomic_fetch_add(gcnt + F.tid, lhist[F.tid], RLX_AGENT);
    __syncthreads();
    for (int s = F.tid; s < gl * 64; s += 512) { const unsigned av = asg[s]; const int e = av >> 16, rank = av & 0xffff; const int g2 = s >> 6, rl = (s >> 2) & 15, k = s & 3;
        const int tok = (F.vcu + g2 * F.G) * 16 + rl; LIST[(size_t)e * LCAP + lbase[e] + rank] = tok * 4 + k; }
}

__device__ __forceinline__ void moe_tables(const Frame& F, const Args& a, int ncol  ) {
    LAS int* tst = (LAS int*)(F.lds + L_TST); LAS int* lcnt = (LAS int*)(F.lds + L_CNT); LAS int* ut = (LAS int*)(F.lds + L_UT);
    unsigned* gcnt = (unsigned*)(a.ws + WS_CTL) + CW_CNT;
    if (F.tid < 32) lcnt[F.tid] = (int)__hip_atomic_load(gcnt + F.tid, RLX_AGENT);
    __syncthreads();
    if (F.tid == 0) { int s = 0; for (int e = 0; e < NE; ++e) { tst[e] = s; s += (lcnt[e] + 255) >> 8; } tst[NE] = s; }
    __syncthreads();
    if (F.tid < 32) { const int i = F.tid; const int T = tst[NE]; const long L = (long)i * F.G + F.vcu; int e = 0, tile = 0, pn = 0, valid = 0, lb = 0, nv = 0;
        if (L < (long)T * ncol) { tile = (int)(L / ncol); pn = (int)(L % ncol); valid = 1; for (int q = 0; q < NE; ++q) if (tst[q + 1] <= tile) e = q + 1;
            const int tin = tile - tst[e]; lb = e * LCAP + tin * 256; nv = lcnt[e] - tin * 256; nv = nv > 256 ? 256 : nv; }
        ut[i * 8 + 0] = e; ut[i * 8 + 1] = tile; ut[i * 8 + 2] = pn; ut[i * 8 + 3] = valid; ut[i * 8 + 4] = lb; ut[i * 8 + 5] = nv; ut[i * 8 + 6] = 0; ut[i * 8 + 7] = 0; }
    __syncthreads();
}

struct P7Buf { u32x4 xw[2][2]; u32x2 yw[2][4][2]; f32x4 gt[2]; };
__device__ __forceinline__ void p7_load(P7Buf& B, const bf16_t* XB, const float* TG, const unsigned char* Y, int row, int lane) {
#pragma unroll
    for (int r = 0; r < 2; ++r) { load_row16_bfw(XB + (size_t)(row + r) * D, lane, B.xw[r]); B.gt[r] = *(const f32x4*)(TG + (size_t)(row + r) * 4);
#pragma unroll
        for (int k = 0; k < 4; ++k)
#pragma unroll
            for (int j = 0; j < 2; ++j) B.yw[r][k][j] = *(const u32x2*)(Y + ((size_t)(row + r) * 4 + k) * D + 8 * lane + 512 * j); }
}
__device__ __forceinline__ void p7_combine_ln2(const Frame& F, const Args& a) {
    bf16_t* XB = (bf16_t*)(a.ws + WS_XB1); const float* TG = (const float*)(a.ws + WS_TG); const unsigned char* Y = a.ws + WS_Y;
    const int lane = F.lane, gw = F.vcu * 8 + F.wave, NGW = F.G * 8;
    float g[16], b[16]; load_row16(a.ln2_g, lane, g); load_row16(a.ln2_b, lane, b);
    P7Buf cur, nxt;
    int row = 2 * gw;
    if (row < M) p7_load(cur, XB, TG, Y, row, lane);
    for (; row < M; row += 2 * NGW) { const int rn = row + 2 * NGW;
        if (rn < M) p7_load(nxt, XB, TG, Y, rn, lane);
        float v[2][16];
#pragma unroll
        for (int r = 0; r < 2; ++r) { unpack_row16(cur.xw[r], v[r]);
#pragma unroll
            for (int i = 0; i < 16; ++i) v[r][i] *= ALPHA;
#pragma unroll
            for (int k = 0; k < 4; ++k) { const float gk = cur.gt[r][k] * (1.0f / Y_MUL);
#pragma unroll
                for (int j = 0; j < 2; ++j) { const u32x2 w = cur.yw[r][k][j];
                    const f32x2 f0 = __builtin_amdgcn_cvt_pk_f32_fp8((int)w.x, false), f1 = __builtin_amdgcn_cvt_pk_f32_fp8((int)w.x, true), f2 = __builtin_amdgcn_cvt_pk_f32_fp8((int)w.y, false), f3 = __builtin_amdgcn_cvt_pk_f32_fp8((int)w.y, true);
                    v[r][8 * j + 0] += gk * f0.x; v[r][8 * j + 1] += gk * f0.y; v[r][8 * j + 2] += gk * f1.x; v[r][8 * j + 3] += gk * f1.y;
                    v[r][8 * j + 4] += gk * f2.x; v[r][8 * j + 5] += gk * f2.y; v[r][8 * j + 6] += gk * f3.x; v[r][8 * j + 7] += gk * f3.y; } } }
        ln_rows2(v, g, b);
#pragma unroll
        for (int r = 0; r < 2; ++r) store_row16_bf(XB + (size_t)(row + r) * D, lane, v[r]);
        if (rn < M) cur = nxt; }
}
__device__ __forceinline__ void p9_ln3(const Frame& F, const Args& a) {
    float* R = a.out; const bf16_t* H3 = (const bf16_t*)(a.ws + WS_H3); const int lane = F.lane, gw = F.vcu * 8 + F.wave, NGW = F.G * 8;
    float g[16], b[16]; load_row16(a.ln3_g, lane, g); load_row16(a.ln3_b, lane, b);
    u32x4 hc[2][2], hn[2][2];
    int row = 2 * gw;
    if (row < M) { load_row16_bfw(H3 + (size_t)row * D, lane, hc[0]); load_row16_bfw(H3 + (size_t)(row + 1) * D, lane, hc[1]); }
    for (; row < M; row += 2 * NGW) { const int rn = row + 2 * NGW; float v[2][16];
        if (rn < M) { load_row16_bfw(H3 + (size_t)rn * D, lane, hn[0]); load_row16_bfw(H3 + (size_t)(rn + 1) * D, lane, hn[1]); }
        unpack_row16(hc[0], v[0]); unpack_row16(hc[1], v[1]);
        ln_rows2(v, g, b);
        store_row16(R + (size_t)row * D, lane, v[0]); store_row16(R + (size_t)(row + 1) * D, lane, v[1]);
        if (rn < M) {
#pragma unroll
            for (int r = 0; r < 2; ++r)
#pragma unroll
                for (int j = 0; j < 2; ++j) hc[r][j] = hn[r][j]; } }
}

__global__ void __launch_bounds__(512, 2) fwd_kernel(Args args) {
    extern __shared__ __attribute__((aligned(16))) unsigned char lds_raw[];
    Frame F;
    F.lds = (LAS unsigned char*)lds_raw;
    F.tid = threadIdx.x; F.lane = F.tid & 63; F.wave = __builtin_amdgcn_readfirstlane(F.tid >> 6);
    F.G = gridDim.x; { const int bx = blockIdx.x; F.vcu = (F.G % 8 == 0) ? (bx % 8) * (F.G / 8) + bx / 8 : bx; }
    unsigned char* ws = args.ws;
    volatile LAS unsigned* MISC = (volatile LAS unsigned*)(F.lds + L_MISC);
    for (int u = F.tid; u < (LDS_BYTES - RING_BYTES) / 4; u += 512) ((LAS unsigned*)(F.lds + RING_BYTES))[u] = 0u;
    __syncthreads();
    XcdBarrier bar; bar.bar = (unsigned*)(ws + WS_CTL) + CW_BAR; bar.x = 0; bar.st = nullptr;
    if (MK_N_LAUNCHES == 1) bar = xcd_barrier_post((unsigned*)(ws + WS_CTL) + CW_BAR, MISC + 8);
    const int lo = args.ph_lo, hi = args.ph_hi;
#ifndef PHASE_MASK
#define PHASE_MASK 0x3ff
#endif
#define IN(k) (((PHASE_MASK >> (k)) & 1) && lo <= (k) && (k) < hi)
#define GRID_BAR(k) do { if (IN(k) && IN((k) + 1)) xcd_barrier(bar); } while (0)

    if (IN(0)) { _Pragma("unroll") for (int rep = 0; rep < REP0; ++rep) p0_prologue(F, args); GRID_BAR(0); }

    if (IN(1)) {
        _Pragma("unroll") for (int rep = 0; rep < REP1; ++rep) {
        { pg8::DenseOrder S; S.init(ws + WS_XB, ws + WS_WIN, M, DIN, 2 * D, F.G, (int)blockIdx.x); pg8::EpiBf16 E{(bf16_t*)(ws + WS_PROJ), DIN};
          pg8::gemm_phase<pg8::EpiBf16, pg8::DenseOrder>(F.lds, 2 * D, S, E); }
        { pg8::DenseOrder S; S.init(ws + WS_PB, ws + WS_WP, M, D, 2 * PLE, F.G, (int)blockIdx.x); pg8::EpiBf16 E{(bf16_t*)(ws + WS_PLE), D};
          pg8::gemm_phase<pg8::EpiBf16, pg8::DenseOrder>(F.lds, 2 * PLE, S, E); }
        }
        GRID_BAR(1);
    }

    if (IN(2)) { _Pragma("unroll") for (int rep = 0; rep < REP2; ++rep) p2_mixer(F, args); GRID_BAR(2); }

    if (IN(3)) {
        pg8::DenseOrder S; S.init(ws + WS_A2, ws + WS_W2, M, D, 2 * D, F.G, (int)blockIdx.x); pg8::EpiH1 E{(const bf16_t*)(ws + WS_XB), (bf16_t*)(ws + WS_XB1)};
        _Pragma("unroll") for (int rep = 0; rep < REP3; ++rep) pg8::gemm_phase<pg8::EpiH1, pg8::DenseOrder>(F.lds, 2 * D, S, E);
        GRID_BAR(3);
    }

    if (IN(4)) { p4_ln1_router(F, args); GRID_BAR(4); }

    if (IN(5)) {
        moe_tables(F, args, 8);
        pg8::MoeGuOrder S; S.ut = (const LAS int*)(F.lds + L_UT); S.A = (const char*)(ws + WS_X1F8); S.Bt = (const char*)(ws + WS_WGU); S.list = (const int*)(ws + WS_LIST); S.KB = D; S.bstride_e = (size_t)2 * FF * D; S.gather = true;
        pg8::EpiGU E{(unsigned char*)(ws + WS_HID), args.b_gu};
        _Pragma("unroll") for (int rep = 0; rep < REP5; ++rep) pg8::gemm_phase<pg8::EpiGU, pg8::MoeGuOrder, true>(F.lds, D, S, E, SCL_WGU, 0x7f7f7f7f);
        GRID_BAR(5);
    }

    if (IN(6)) {
        moe_tables(F, args, 4);
        pg8::MoeDnOrder S; S.ut = (const LAS int*)(F.lds + L_UT); S.A = (const char*)(ws + WS_HID); S.Bt = (const char*)(ws + WS_WDN); S.list = (const int*)(ws + WS_LIST); S.KB = FF; S.bstride_e = (size_t)D * FF; S.gather = false;
        pg8::EpiDown E{ws + WS_Y, args.b_dn, (const int*)(ws + WS_LIST)};
        _Pragma("unroll") for (int rep = 0; rep < REP6; ++rep) pg8::gemm_phase<pg8::EpiDown, pg8::MoeDnOrder, true>(F.lds, FF, S, E, SCL_WDN, SCL_HID);
        GRID_BAR(6);
    }

    if (IN(7)) { p7_combine_ln2(F, args); GRID_BAR(7); }

    if (IN(8)) {
        pg8::DenseOrder S; S.init(ws + WS_XB1, ws + WS_WG, M, D, 2 * D, F.G, (int)blockIdx.x); pg8::EpiGate E{(const bf16_t*)(ws + WS_XB1), (const bf16_t*)(ws + WS_PLE), args.ple_gate_b, (bf16_t*)(ws + WS_H3)};
        pg8::gemm_phase<pg8::EpiGate, pg8::DenseOrder>(F.lds, 2 * D, S, E);
        GRID_BAR(8);
    }

    if (IN(9)) { p9_ln3(F, args); }
#undef IN
#undef GRID_BAR
}

extern "C" void kernel_launch(void* const* d_in, const int* in_sizes, int n_in, void* d_out, int out_size, void* d_ws, size_t ws_size, hipStream_t stream) {
    static int grid = 0;
    if (grid == 0) {
        if (n_in != 22 || in_sizes[0] != M * D || out_size != M * D || ws_size < WS_END) { fprintf(stderr, "kernel_launch: unexpected shapes (n_in %d, in0 %d, out %d, ws %zu); nothing launched\n", n_in, n_in > 0 ? in_sizes[0] : -1, out_size, ws_size); grid = -1; return; }
        int dev = 0, cus = 0, per_cu = 0;
        if (hipGetDevice(&dev) != hipSuccess || hipDeviceGetAttribute(&cus, hipDeviceAttributeMultiprocessorCount, dev) != hipSuccess) { grid = -1; return; }
        if (hipFuncSetAttribute((const void*)fwd_kernel, hipFuncAttributeMaxDynamicSharedMemorySize, LDS_BYTES) != hipSuccess) { fprintf(stderr, "kernel_launch: hipFuncSetAttribute failed\n"); grid = -1; return; }
        if (hipOccupancyMaxActiveBlocksPerMultiprocessor(&per_cu, (const void*)fwd_kernel, 512, LDS_BYTES) != hipSuccess || per_cu < 1) fprintf(stderr, "kernel_launch: occupancy query reports %d\n", per_cu);
        (void)hipGetLastError();
        grid = cus;
        if (grid != 256) fprintf(stderr, "kernel_launch: %d CUs (expected 256)\n", grid);
    }
    if (grid < 0) return;
    (void)hipMemsetAsync((char*)d_ws + WS_CTL, 0, CTL_ZERO_BYTES, stream);
    Args a{};
    const float** ap = (const float**)&a;
    for (int i = 0; i < 22; ++i) ap[i] = (const float*)d_in[i];
    a.out = (float*)d_out; a.ws = (unsigned char*)d_ws;
#if MK_N_LAUNCHES == 1
    a.ph_lo = 0; a.ph_hi = NPHASE;
    hipLaunchKernelGGL(fwd_kernel, dim3(grid), dim3(512), LDS_BYTES, stream, a);
#else
    for (int ph = 0; ph < NPHASE; ++ph) { a.ph_lo = ph; a.ph_hi = ph + 1; hipLaunchKernelGGL(fwd_kernel, dim3(grid), dim3(512), LDS_BYTES, stream, a); }
#endif
}
```
